# Optimizing an MI355X kernel written in HIP

```python
import numpy as np
import jax
import jax.numpy as jnp
from jax import lax

D_MODEL = 1024
BATCH = 16
SEQ = 2048
DEPTH = 2

HEAD_DIM = 64
ROT_DIM = HEAD_DIM // 4
ROPE_THETA = 500000.0
NORM_EPS = 1e-6
Q_BLOCK = 128
D_FF = 2816
NEG_INF = -1e30

A_GROUPS = 4
A_CHUNK = 128
A_WIDTH = A_GROUPS * HEAD_DIM
B_HEADS = 12
B_KV_HEADS = 3
B_WIDTH = B_HEADS * HEAD_DIM
B_KV_WIDTH = B_KV_HEADS * HEAD_DIM
CMP_LEN = 32
CMP_STRIDE = 16
CMP_HIDDEN = 256
SLC_BLOCK = 64
SLC_TOPN = 8
WINDOW = 512
N_BRANCH = 3
FORCE_SCORE = 1e4
C_HEADS = 8
C_WIDTH = C_HEADS * HEAD_DIM
IDX_HEADS = 4
IDX_DIM = 32
IDX_ROT = IDX_DIM // 4
DSA_TOPK = 256
D_HEADS = 8
D_WIDTH = D_HEADS * HEAD_DIM
MOBA_BLOCK = 256
MOBA_TOPK = 3

EVEN_SPLITS = (2 * A_WIDTH, B_WIDTH) + (B_KV_WIDTH,) * 6 + (B_HEADS * N_BRANCH,)
ODD_SPLITS = (C_WIDTH, HEAD_DIM, HEAD_DIM, IDX_HEADS * IDX_DIM, IDX_DIM, IDX_HEADS, D_WIDTH, D_WIDTH, D_WIDTH)
EVEN_IN = sum(EVEN_SPLITS)
ODD_IN = sum(ODD_SPLITS)
MIX_OUT = A_WIDTH + B_WIDTH
N_EVEN = (DEPTH + 1) // 2
N_ODD = DEPTH // 2

kernel_name = 'hybrid_gmlp_nsa_dsa_moba_macaron'


def rmsnorm(x, g):
    xf = x.astype(jnp.float32)
    y = xf * lax.rsqrt(jnp.mean(xf * xf, axis=-1, keepdims=True) + NORM_EPS)
    return (y * g.astype(jnp.float32)).astype(x.dtype)


def rope_tables(positions, rot_dim):
    inv_freq = ROPE_THETA ** (-jnp.arange(0, rot_dim, 2, dtype=jnp.float32) / rot_dim)
    ang = positions.astype(jnp.float32)[..., None] * inv_freq
    return jnp.cos(ang), jnp.sin(ang)


def partial_rope(x, cos, sin):
    half = cos.shape[-1]
    bshape = cos.shape[:2] + (1,) * (x.ndim - 3) + (half,)
    c = cos.reshape(bshape).astype(x.dtype)
    s = sin.reshape(bshape).astype(x.dtype)
    x1, x2, rest = x[..., :half], x[..., half:2 * half], x[..., 2 * half:]
    return jnp.concatenate([x1 * c - x2 * s, x2 * c + x1 * s, rest], axis=-1)


def masked_softmax(s, mask):
    s = jnp.where(mask, s.astype(jnp.float32), NEG_INF)
    return jnp.where(mask, jax.nn.softmax(s, axis=-1), 0.0)


def swiglu_ffn(x, g, w_gate, w_up, w_down):
    h = rmsnorm(x, g)
    return (jax.nn.silu(h @ w_gate) * (h @ w_up)) @ w_down


def split_cols(z, sizes):
    return jnp.split(z, [int(c) for c in np.cumsum(sizes)[:-1]], axis=-1)


def rows(a, b, q0):
    return lax.dynamic_slice_in_dim(a[b], q0, Q_BLOCK, axis=0)


def map_query_blocks(fn, batch, seq):
    n_qb = seq // Q_BLOCK

    def step(i):
        return fn(i // n_qb, (i % n_qb) * Q_BLOCK)

    out = lax.map(step, jnp.arange(batch * n_qb, dtype=jnp.int32))
    return out.reshape((batch, seq) + out.shape[2:])


def chunked_gmlp(z, sgu_norm, sgu_w, sgu_b):
    bsz, seq, _ = z.shape
    u, v = jnp.split(jax.nn.gelu(z), 2, axis=-1)
    v = rmsnorm(v, sgu_norm).reshape(bsz, seq // A_CHUNK, A_CHUNK, A_GROUPS, HEAD_DIM)
    causal = jnp.tril(jnp.ones((A_CHUNK, A_CHUNK), dtype=bool))
    w = jnp.where(causal, sgu_w, jnp.zeros_like(sgu_w))
    mixed = jnp.einsum('gts,bcsgd->bctgd', w, v) + sgu_b.T[:, :, None]
    return u * mixed.reshape(bsz, seq, A_WIDTH)


def compress_blocks(t, pos_emb, w1, w2):
    bsz, seq = t.shape[:2]
    n_cmp = (seq - CMP_LEN) // CMP_STRIDE + 1
    idx = jnp.arange(n_cmp)[:, None] * CMP_STRIDE + jnp.arange(CMP_LEN)[None, :]
    blk = t[:, idx] + pos_emb[:, None, :]
    blk = jnp.moveaxis(blk, 3, 2).reshape(bsz, n_cmp, B_KV_HEADS, CMP_LEN * HEAD_DIM)
    return jax.nn.gelu(blk @ w1) @ w2


def cmp_to_slc_overlap(n_cmp, n_slc):
    c0 = np.arange(n_cmp) * CMP_STRIDE
    s0 = np.arange(n_slc) * SLC_BLOCK
    m = (c0[:, None] < s0[None, :] + SLC_BLOCK) & (c0[:, None] + CMP_LEN > s0[None, :])
    return jnp.asarray(m, dtype=jnp.float32)


def nsa_attention(q_rot, q_raw, k_cmp, v_cmp, k_slc, v_slc, k_win, v_win, gates):
    bsz, seq = q_rot.shape[:2]
    grp = B_HEADS // B_KV_HEADS
    scale = HEAD_DIM ** -0.5
    n_cmp = k_cmp.shape[1]
    n_slc = seq // SLC_BLOCK
    top_n = min(SLC_TOPN, n_slc)
    overlap = cmp_to_slc_overlap(n_cmp, n_slc)
    cmp_end = jnp.arange(n_cmp) * CMP_STRIDE + CMP_LEN - 1
    blk_id = jnp.arange(n_slc)
    k_blk = k_slc.reshape(bsz, n_slc, SLC_BLOCK, B_KV_HEADS, HEAD_DIM).transpose(0, 3, 1, 2, 4)
    v_blk = v_slc.reshape(bsz, n_slc, SLC_BLOCK, B_KV_HEADS, HEAD_DIM).transpose(0, 3, 1, 2, 4)
    pad = jnp.zeros((bsz, WINDOW, B_KV_HEADS, HEAD_DIM), k_win.dtype)
    k_win_p = jnp.concatenate([pad, k_win], axis=1)
    v_win_p = jnp.concatenate([pad, v_win], axis=1)
    g_idx = jnp.arange(B_KV_HEADS)[:, None, None]
    win_off = jnp.arange(Q_BLOCK + WINDOW) - WINDOW

    def block(b, q0):
        t = q0 + jnp.arange(Q_BLOCK)
        qr = rows(q_rot, b, q0).reshape(Q_BLOCK, B_KV_HEADS, grp, HEAD_DIM)
        qn = rows(q_raw, b, q0).reshape(Q_BLOCK, B_KV_HEADS, grp, HEAD_DIM)
        s_c = jnp.einsum('qgrd,ngd->grqn', qn, k_cmp[b]) * scale
        p_c = masked_softmax(s_c, cmp_end[None, :] <= t[:, None])
        o_c = jnp.einsum('grqn,ngd->qgrd', p_c.astype(v_cmp.dtype), v_cmp[b])
        imp = jnp.einsum('grqn,nj->gqj', p_c, overlap)
        admissible = blk_id[None, :] * SLC_BLOCK <= t[:, None]
        forced = (blk_id[None, :] == 0) | (blk_id[None, :] == t[:, None] // SLC_BLOCK)
        imp = jnp.where(admissible, jnp.where(forced, FORCE_SCORE, imp), NEG_INF)
        _, sel = lax.top_k(imp, top_n)
        sel_ok = jnp.take_along_axis(jnp.broadcast_to(admissible, imp.shape), sel, axis=-1)
        ks = k_blk[b][g_idx, sel].reshape(B_KV_HEADS, Q_BLOCK, top_n * SLC_BLOCK, HEAD_DIM)
        vs = v_blk[b][g_idx, sel].reshape(B_KV_HEADS, Q_BLOCK, top_n * SLC_BLOCK, HEAD_DIM)
        tok = (sel[..., None] * SLC_BLOCK + jnp.arange(SLC_BLOCK)).reshape(B_KV_HEADS, Q_BLOCK, top_n * SLC_BLOCK)
        m_s = (tok <= t[None, :, None]) & jnp.repeat(sel_ok, SLC_BLOCK, axis=-1)
        s_s = jnp.einsum('qgrd,gqkd->grqk', qr, ks) * scale
        p_s = masked_softmax(s_s, m_s[:, None])
        o_s = jnp.einsum('grqk,gqkd->qgrd', p_s.astype(vs.dtype), vs)
        kw = lax.dynamic_slice_in_dim(k_win_p[b], q0, Q_BLOCK + WINDOW, axis=0)
        vw = lax.dynamic_slice_in_dim(v_win_p[b], q0, Q_BLOCK + WINDOW, axis=0)
        s_pos = q0 + win_off
        m_w = (s_pos[None, :] <= t[:, None]) & (s_pos[None, :] > t[:, None] - WINDOW) & (s_pos[None, :] >= 0)
        s_w = jnp.einsum('qgrd,kgd->grqk', qr, kw) * scale
        p_w = masked_softmax(s_w, m_w)
        o_w = jnp.einsum('grqk,kgd->qgrd', p_w.astype(vw.dtype), vw)
        g = rows(gates, b, q0).reshape(Q_BLOCK, B_KV_HEADS, grp, N_BRANCH)
        o = g[..., 0:1] * o_c + g[..., 1:2] * o_s + g[..., 2:3] * o_w
        return o.reshape(Q_BLOCK, B_WIDTH)

    return map_query_blocks(block, bsz, seq)


def dsa_attention(q, k, v, q_idx, k_idx, w_idx):
    bsz, seq = q.shape[:2]
    top_k = min(DSA_TOPK, seq // 4)
    scale = HEAD_DIM ** -0.5
    key_pos = jnp.arange(seq)

    def block(b, q0):
        t = q0 + jnp.arange(Q_BLOCK)
        qb = rows(q, b, q0)
        logits = jnp.einsum('qhd,sd->qhs', rows(q_idx, b, q0), k_idx[b]).astype(jnp.float32) * IDX_DIM ** -0.5
        score = jnp.einsum('qh,qhs->qs', rows(w_idx, b, q0).astype(jnp.float32), jax.nn.relu(logits)) * IDX_HEADS ** -0.5
        score = jnp.where(key_pos[None, :] <= t[:, None], score, NEG_INF)
        _, sel = lax.top_k(score, top_k)
        ok = sel <= t[:, None]
        ks = k[b][sel]
        vs = v[b][sel]
        s = jnp.einsum('qhd,qkd->hqk', qb, ks) * scale
        p = masked_softmax(s, ok[None])
        o = jnp.einsum('hqk,qkd->qhd', p.astype(vs.dtype), vs)
        return o.reshape(Q_BLOCK, C_WIDTH)

    return map_query_blocks(block, bsz, seq)


def moba_attention(q, k, v):
    bsz, seq = q.shape[:2]
    n_blk = -(-seq // MOBA_BLOCK)
    pad = n_blk * MOBA_BLOCK - seq
    scale = HEAD_DIM ** -0.5
    k_blk = jnp.pad(k, ((0, 0), (0, pad), (0, 0), (0, 0))).reshape(bsz, n_blk, MOBA_BLOCK, D_HEADS, HEAD_DIM).transpose(0, 3, 1, 2, 4)
    v_blk = jnp.pad(v, ((0, 0), (0, pad), (0, 0), (0, 0))).reshape(bsz, n_blk, MOBA_BLOCK, D_HEADS, HEAD_DIM).transpose(0, 3, 1, 2, 4)
    k_mean = k_blk.mean(axis=3)
    top_k = min(MOBA_TOPK, n_blk - 1)
    blk_id = jnp.arange(n_blk)
    h_idx = jnp.arange(D_HEADS)[:, None, None]

    def block(b, q0):
        t = q0 + jnp.arange(Q_BLOCK)
        qb = rows(q, b, q0)
        own = q0 // MOBA_BLOCK
        k_own = lax.dynamic_index_in_dim(k_blk[b], own, axis=1, keepdims=False)
        v_own = lax.dynamic_index_in_dim(v_blk[b], own, axis=1, keepdims=False)
        own_pos = own * MOBA_BLOCK + jnp.arange(MOBA_BLOCK)
        s_own = jnp.einsum('qhd,hkd->hqk', qb, k_own) * scale
        m_own = jnp.broadcast_to(own_pos[None, :] <= t[:, None], s_own.shape)
        if top_k == 0:
            p = masked_softmax(s_own, m_own)
            o = jnp.einsum('hqk,hkd->qhd', p.astype(v_own.dtype), v_own)
        else:
            gate = jnp.einsum('qhd,hjd->hqj', qb, k_mean[b]).astype(jnp.float32)
            gate = jnp.where(blk_id < own, gate, NEG_INF)
            _, sel = lax.top_k(gate, top_k)
            ok = sel < own
            n_sel = top_k * MOBA_BLOCK
            ks = k_blk[b][h_idx, sel].reshape(D_HEADS, Q_BLOCK, n_sel, HEAD_DIM)
            vs = v_blk[b][h_idx, sel].reshape(D_HEADS, Q_BLOCK, n_sel, HEAD_DIM)
            s_sel = jnp.einsum('qhd,hqkd->hqk', qb, ks) * scale
            m_sel = jnp.repeat(ok, MOBA_BLOCK, axis=-1)
            p = masked_softmax(jnp.concatenate([s_sel, s_own], axis=-1), jnp.concatenate([m_sel, m_own], axis=-1))
            o = (jnp.einsum('hqk,hqkd->qhd', p[..., :n_sel].astype(vs.dtype), vs)
                 + jnp.einsum('hqk,hkd->qhd', p[..., n_sel:].astype(v_own.dtype), v_own))
        return o.reshape(Q_BLOCK, D_WIDTH)

    return map_query_blocks(block, bsz, seq)


def even_mixer(h, cos, sin, w_in, sgu_norm, sgu_w, sgu_b, cmp_pos_k, cmp_w1_k, cmp_w2_k,
               cmp_pos_v, cmp_w1_v, cmp_w2_v, w_out):
    bsz, seq, _ = h.shape
    a_in, q, kc, vc, ksl, vsl, kw, vw, gl = split_cols(h @ w_in, EVEN_SPLITS)

    def kv(t):
        return t.reshape(bsz, seq, B_KV_HEADS, HEAD_DIM)

    q_raw = q.reshape(bsz, seq, B_HEADS, HEAD_DIM)
    a_out = chunked_gmlp(a_in, sgu_norm, sgu_w, sgu_b)
    b_out = nsa_attention(partial_rope(q_raw, cos, sin), q_raw,
                          compress_blocks(kv(kc), cmp_pos_k, cmp_w1_k, cmp_w2_k),
                          compress_blocks(kv(vc), cmp_pos_v, cmp_w1_v, cmp_w2_v),
                          partial_rope(kv(ksl), cos, sin), kv(vsl),
                          partial_rope(kv(kw), cos, sin), kv(vw),
                          jax.nn.sigmoid(gl).reshape(bsz, seq, B_HEADS, N_BRANCH))
    return jnp.concatenate([a_out, b_out], axis=-1) @ w_out


def odd_mixer(h, cos, sin, cos_i, sin_i, w_in, w_out):
    bsz, seq, _ = h.shape
    qc, kc, vc, qi, ki, wi, qd, kd, vd = split_cols(h @ w_in, ODD_SPLITS)
    c_out = dsa_attention(partial_rope(qc.reshape(bsz, seq, C_HEADS, HEAD_DIM), cos, sin),
                          partial_rope(kc, cos, sin), vc,
                          partial_rope(qi.reshape(bsz, seq, IDX_HEADS, IDX_DIM), cos_i, sin_i),
                          partial_rope(ki, cos_i, sin_i), wi)
    d_out = moba_attention(partial_rope(qd.reshape(bsz, seq, D_HEADS, HEAD_DIM), cos, sin),
                           partial_rope(kd.reshape(bsz, seq, D_HEADS, HEAD_DIM), cos, sin),
                           vd.reshape(bsz, seq, D_HEADS, HEAD_DIM))
    return jnp.concatenate([c_out, d_out], axis=-1) @ w_out


def setup_inputs(seed: int = 0) -> dict:
    key = jax.random.key(seed)
    keys = iter(jax.random.split(key, 40))

    def nrm(shape, scale):
        return jax.random.normal(next(keys), shape, jnp.float32) * scale

    def gain(shape):
        return 1.0 + nrm(shape, 0.1)

    x = nrm((BATCH, SEQ, D_MODEL), 1.0)
    offset = jax.random.randint(next(keys), (BATCH, 1), 0, 4096, dtype=jnp.int32)
    positions = offset + jnp.arange(SEQ, dtype=jnp.int32)[None, :]
    return {
        'x': x,
        'positions': positions,
        'ffn1_norm': gain((DEPTH, D_MODEL)),
        'ffn1_w_gate': nrm((DEPTH, D_MODEL, D_FF), D_MODEL ** -0.5),
        'ffn1_w_up': nrm((DEPTH, D_MODEL, D_FF), D_MODEL ** -0.5),
        'ffn1_w_down': nrm((DEPTH, D_FF, D_MODEL), D_FF ** -0.5),
        'mix_norm': gain((DEPTH, D_MODEL)),
        'ffn2_norm': gain((DEPTH, D_MODEL)),
        'ffn2_w_gate': nrm((DEPTH, D_MODEL, D_FF), D_MODEL ** -0.5),
        'ffn2_w_up': nrm((DEPTH, D_MODEL, D_FF), D_MODEL ** -0.5),
        'ffn2_w_down': nrm((DEPTH, D_FF, D_MODEL), D_FF ** -0.5),
        'ev_w_in': nrm((N_EVEN, D_MODEL, EVEN_IN), D_MODEL ** -0.5),
        'ev_sgu_norm': gain((N_EVEN, A_WIDTH)),
        'ev_sgu_w': nrm((N_EVEN, A_GROUPS, A_CHUNK, A_CHUNK), A_CHUNK ** -0.5),
        'ev_sgu_b': gain((N_EVEN, A_GROUPS, A_CHUNK)),
        'ev_cmp_pos_k': nrm((N_EVEN, CMP_LEN, HEAD_DIM), 0.1),
        'ev_cmp_w1_k': nrm((N_EVEN, CMP_LEN * HEAD_DIM, CMP_HIDDEN), (CMP_LEN * HEAD_DIM) ** -0.5),
        'ev_cmp_w2_k': nrm((N_EVEN, CMP_HIDDEN, HEAD_DIM), CMP_HIDDEN ** -0.5),
        'ev_cmp_pos_v': nrm((N_EVEN, CMP_LEN, HEAD_DIM), 0.1),
        'ev_cmp_w1_v': nrm((N_EVEN, CMP_LEN * HEAD_DIM, CMP_HIDDEN), (CMP_LEN * HEAD_DIM) ** -0.5),
        'ev_cmp_w2_v': nrm((N_EVEN, CMP_HIDDEN, HEAD_DIM), CMP_HIDDEN ** -0.5),
        'ev_w_out': nrm((N_EVEN, MIX_OUT, D_MODEL), MIX_OUT ** -0.5),
        'od_w_in': nrm((N_ODD, D_MODEL, ODD_IN), D_MODEL ** -0.5),
        'od_w_out': nrm((N_ODD, MIX_OUT, D_MODEL), MIX_OUT ** -0.5),
        'final_norm': gain((D_MODEL,)),
    }


def reference(x, positions, ffn1_norm, ffn1_w_gate, ffn1_w_up, ffn1_w_down, mix_norm,
              ffn2_norm, ffn2_w_gate, ffn2_w_up, ffn2_w_down, ev_w_in, ev_sgu_norm, ev_sgu_w,
              ev_sgu_b, ev_cmp_pos_k, ev_cmp_w1_k, ev_cmp_w2_k, ev_cmp_pos_v, ev_cmp_w1_v,
              ev_cmp_w2_v, ev_w_out, od_w_in, od_w_out, final_norm):
    cos, sin = rope_tables(positions, ROT_DIM)
    cos_i, sin_i = rope_tables(positions, IDX_ROT)
    for i in range(DEPTH):
        x = x + 0.5 * swiglu_ffn(x, ffn1_norm[i], ffn1_w_gate[i], ffn1_w_up[i], ffn1_w_down[i])
        h = rmsnorm(x, mix_norm[i])
        if i % 2 == 0:
            e = i // 2
            x = x + even_mixer(h, cos, sin, ev_w_in[e], ev_sgu_norm[e], ev_sgu_w[e], ev_sgu_b[e],
                               ev_cmp_pos_k[e], ev_cmp_w1_k[e], ev_cmp_w2_k[e],
                               ev_cmp_pos_v[e], ev_cmp_w1_v[e], ev_cmp_w2_v[e], ev_w_out[e])
        else:
            o = i // 2
            x = x + odd_mixer(h, cos, sin, cos_i, sin_i, od_w_in[o], od_w_out[o])
        x = x + 0.5 * swiglu_ffn(x, ffn2_norm[i], ffn2_w_gate[i], ffn2_w_up[i], ffn2_w_down[i])
    return rmsnorm(x, final_norm)
```

```cpp
#include <hip/hip_runtime.h>
#include <stdint.h>
#include <stdio.h>

#define LAS __attribute__((address_space(3)))
typedef unsigned short bf16_t;
typedef short bf16x8 __attribute__((ext_vector_type(8)));
typedef short s16x4 __attribute__((ext_vector_type(4)));
typedef float f32x4 __attribute__((ext_vector_type(4)));
typedef float f32x16 __attribute__((ext_vector_type(16)));
typedef unsigned u32x4 __attribute__((ext_vector_type(4)));
typedef unsigned u32x2 __attribute__((ext_vector_type(2)));

namespace cfg {
constexpr int B = 16, S = 2048, D = 1024, M = B * S, FF = 2816, NGU = 2 * FF, ZLD = 2560, NTHR = 512;
constexpr int EV_NSRC = 2468, OD_NSRC = 2340;
constexpr int E_A = 0, E_Q = 512, E_KC = 1280, E_VC = 1472, E_KS = 1664, E_VS = 1856, E_KW = 2048, E_VW = 2240, E_GL = 2432;
constexpr int O_QC = 0, O_KC = 512, O_VC = 576, O_QI = 640, O_KI = 768, O_QD = 832, O_KD = 1344, O_VD = 1856, O_WI = 2368;
constexpr float EPS = 1e-6f;
constexpr float C2 = 0.125f * 1.4426950408889634f;
constexpr int LDS_BYTES = 144 * 1024;
}

namespace wsm {
constexpr size_t al(size_t x) { return (x + 255) & ~(size_t)255; }
constexpr size_t CTL = 0, CTL_BYTES = 16384;
constexpr size_t WGU = CTL + CTL_BYTES;                                  constexpr size_t WGU_1 = (size_t)cfg::NGU * cfg::D * 2;
constexpr size_t WD = WGU + 4 * WGU_1;                                   constexpr size_t WD_1 = (size_t)cfg::D * cfg::FF * 2;
constexpr size_t WIN = WD + 4 * WD_1;                                    constexpr size_t WIN_1 = (size_t)cfg::ZLD * cfg::D * 2;
constexpr size_t WOUT = WIN + 2 * WIN_1;                                 constexpr size_t WOUT_1 = (size_t)cfg::D * cfg::D * 2;
constexpr size_t CW1T = WOUT + 2 * WOUT_1;                               constexpr size_t CW1T_1 = (size_t)256 * 2048 * 2;
constexpr size_t CW2T = CW1T + 2 * CW1T_1;                               constexpr size_t CW2T_1 = (size_t)64 * 256 * 2;
constexpr size_t SGUW = CW2T + 2 * CW2T_1;
constexpr size_t C1P = SGUW + (size_t)4 * 128 * 128 * 2;
constexpr size_t ROPE16 = C1P + (size_t)2 * 32 * 256 * 4;
constexpr size_t ROPE8 = ROPE16 + (size_t)cfg::M * 16 * 4;
constexpr size_t SSQ = ROPE8 + (size_t)cfg::M * 8 * 4;
constexpr size_t XB = SSQ + (size_t)cfg::M * 16 * 4;
constexpr size_t ACTZ = XB + (size_t)cfg::M * cfg::D * 2;
constexpr size_t QROT = ACTZ + (size_t)cfg::M * cfg::FF * 2;
constexpr size_t MIX = QROT + (size_t)cfg::M * 768 * 2;
constexpr size_t KCMP = MIX + (size_t)cfg::M * 1024 * 2;
constexpr size_t VCMP = KCMP + (size_t)cfg::B * 3 * 128 * 64 * 2;
constexpr size_t DMASK = VCMP + (size_t)cfg::B * 3 * 128 * 64 * 2;
constexpr size_t KMEAN = DMASK + (size_t)cfg::M * 64 * 4;
constexpr size_t END = KMEAN + (size_t)cfg::B * 8 * 8 * 64 * 4;
static_assert(WGU % 256 == 0 && WD % 256 == 0 && ACTZ % 256 == 0 && QROT % 256 == 0 && KCMP % 256 == 0 && DMASK % 256 == 0, "alignment");
}

struct Args {
    const float* in[25];
    float* out;
    unsigned char* ws;
    int ph_lo, ph_hi;
};

__device__ __forceinline__ float bf2f(bf16_t b) { return __uint_as_float(((unsigned)b) << 16); }
__device__ __forceinline__ float bflo(unsigned w) { return __uint_as_float(w << 16); }
__device__ __forceinline__ float bfhi(unsigned w) { return __uint_as_float(w & 0xffff0000u); }
__device__ __forceinline__ bf16_t f2bf(float f) { unsigned u = __float_as_uint(f); u += 0x7FFFu + ((u >> 16) & 1u); return (bf16_t)(u >> 16); }
__device__ __forceinline__ unsigned pk2(float lo, float hi) { unsigned r; asm volatile("v_cvt_pk_bf16_f32 %0, %1, %2" : "=v"(r) : "v"(lo), "v"(hi)); return r; }
__device__ __forceinline__ float fast_exp(float x) { return __builtin_amdgcn_exp2f(x * 1.4426950408889634f); }
__device__ __forceinline__ float sigmoidf_(float x) { return __builtin_amdgcn_rcpf(1.0f + fast_exp(-x)); }
__device__ __forceinline__ float gelu_tanh(float x) { const float y = 1.5957691216057308f * (x + 0.044715f * x * x * x); return x * sigmoidf_(y); }
__device__ __forceinline__ int crow(int r, int hi) { return (r & 3) + 8 * (r >> 2) + 4 * hi; }
__device__ __forceinline__ float swap32_max(float m) { auto rr = __builtin_amdgcn_permlane32_swap(__float_as_uint(m), __float_as_uint(m), false, false); return __builtin_fmaxf(__uint_as_float(rr[0]), __uint_as_float(rr[1])); }
__device__ __forceinline__ float swap32_sum(float m) { auto rr = __builtin_amdgcn_permlane32_swap(__float_as_uint(m), __float_as_uint(m), false, false); return __uint_as_float(rr[0]) + __uint_as_float(rr[1]); }
#define MFMA32(a, b, c) __builtin_amdgcn_mfma_f32_32x32x16_bf16(a, b, c, 0, 0, 0)
#define MFMA16(a, b, c) __builtin_amdgcn_mfma_f32_16x16x32_bf16(a, b, c, 0, 0, 0)
__device__ __forceinline__ s16x4 tr16(const char* p) { typedef short v4i16_t __attribute__((ext_vector_type(4))); return __builtin_bit_cast(s16x4, __builtin_amdgcn_ds_read_tr16_b64_v4i16((LAS v4i16_t*)p)); }
__device__ __forceinline__ float rstd_from_ssq(const float* ssq, int row) {
    const f32x4* p = (const f32x4*)(ssq + (size_t)row * 16); const f32x4 a = p[0], b = p[1], c = p[2], d = p[3];
    const float s = ((a[0] + a[1]) + (a[2] + a[3])) + ((b[0] + b[1]) + (b[2] + b[3])) + ((c[0] + c[1]) + (c[2] + c[3])) + ((d[0] + d[1]) + (d[2] + d[3]));
    return __builtin_amdgcn_rsqf(s * (1.0f / 1024.0f) + cfg::EPS);
}
namespace pg8 {
#define PG8_LAS __attribute__((address_space(3)))
typedef unsigned short bf16_t;
typedef short bf16x8 __attribute__((ext_vector_type(8)));
typedef float f32x4 __attribute__((ext_vector_type(4)));
typedef unsigned u32x4 __attribute__((ext_vector_type(4)));
constexpr int BM = 256, BK = 64, HALF = 128, HTB = HALF * BK * 2  , STAGE_BYTES = 8 * HTB, NXCD = 8, WGM = 8;

__host__ __device__ __forceinline__ int lds_byte(int r, int c) { const int st = (r >> 4) * 2 + (c >> 5), rr = r & 15, cc = c & 31, ob = rr * 64 + cc * 2; return st * 1024 + (ob ^ (((ob >> 9) & 1) << 5)); }
__host__ __device__ __forceinline__ void stage_rc(int b, int& R, int& C) { const int st = b / 1024, sb = b % 1024, swz = sb ^ (((sb >> 9) & 1) << 5); R = (st >> 1) * 16 + swz / 64; C = (st & 1) * 32 + (swz % 64) / 2; }
__host__ __device__ __forceinline__ int perm32(int rho) { const int n = rho >> 4, i = rho & 15; return 8 * (i >> 2) + 4 * n + (i & 3); }

struct Unit { int pm, pn; };
struct Gemm { const bf16_t* A; const bf16_t* Bt; int M, N, K; };

struct StaticOrder {
    int nM, nN, nwg, G, c;
    __host__ __device__ void init(int M, int N, int G_, int c_) { nM = M / BM; nN = N / BM; nwg = nM * nN; G = G_; c = c_; }
    __host__ __device__ bool next(int i, Unit& u) const {
        const long L = (long)i * G + c; if (L >= nwg) return false;
        int wgid = (int)L; { const int q = nwg / NXCD, r = nwg % NXCD, xcd = wgid % NXCD, off = wgid / NXCD; wgid = (xcd < r ? xcd * (q + 1) : r * (q + 1) + (xcd - r) * q) + off; }
        const int nig = WGM * nN, gid = wgid / nig, fm = gid * WGM, gsz = (nM - fm) < WGM ? (nM - fm) : WGM;
        u.pm = fm + ((wgid % nig) % gsz); u.pn = (wgid % nig) / gsz; return true;
    }
    __device__ __forceinline__ void a_ready(const Unit&) const {}
    __device__ __forceinline__ void done(const Unit&) const {}
};
__device__ __forceinline__ unsigned cvt_pk_bf16(float lo, float hi) { unsigned r; asm volatile("v_cvt_pk_bf16_f32 %0, %1, %2" : "=v"(r) : "v"(lo), "v"(hi)); return r; }
typedef float f32x2 __attribute__((ext_vector_type(2)));
struct EpiSwiGLU {
    static constexpr bool PERM = true, AFTER_DRAIN = false;
    bf16_t* act; const float* ssq;
    __device__ __forceinline__ void operator()(const f32x4 (&acc)[2][2][4][2], const Unit& u, int wr, int wc, int fr, int fq) const {
        const int row0 = u.pm * BM + wr * 64 + fr, col0 = u.pn * 128 + wc * 32 + 8 * fq;
#pragma unroll
        for (int ai = 0; ai < 2; ++ai)
#pragma unroll
            for (int m = 0; m < 4; ++m) {
                const int row = row0 + ai * HALF + m * 16; const float rs = rstd_from_ssq(ssq, row);
                float o[8];
#pragma unroll
                for (int n = 0; n < 2; ++n)
#pragma unroll
                    for (int j = 0; j < 4; ++j) { const float g = acc[ai][0][m][n][j] * rs, up = acc[ai][1][m][n][j] * rs; o[n * 4 + j] = g * sigmoidf_(g) * up; }
                u32x4 w; w.x = pk2(o[0], o[1]); w.y = pk2(o[2], o[3]); w.z = pk2(o[4], o[5]); w.w = pk2(o[6], o[7]);
                *(u32x4*)(act + (size_t)row * cfg::FF + col0) = w;
            }
    }
};
struct EpiZ {
    static constexpr bool PERM = true, AFTER_DRAIN = false;
    bf16_t* z; int ldc; const float* ssq;
    __device__ __forceinline__ void operator()(const f32x4 (&acc)[2][2][4][2], const Unit& u, int wr, int wc, int fr, int fq) const {
        const int row0 = u.pm * BM + wr * 64 + fr, col0 = u.pn * BM + wc * 32 + 8 * fq;
#pragma unroll
        for (int ai = 0; ai < 2; ++ai)
#pragma unroll
            for (int m = 0; m < 4; ++m) {
                const int row = row0 + ai * HALF + m * 16; const float rs = rstd_from_ssq(ssq, row);
#pragma unroll
                for (int bj = 0; bj < 2; ++bj) { const f32x4 v0 = acc[ai][bj][m][0] * rs, v1 = acc[ai][bj][m][1] * rs;
                    u32x4 w; w.x = pk2(v0[0], v0[1]); w.y = pk2(v0[2], v0[3]); w.z = pk2(v1[0], v1[1]); w.w = pk2(v1[2], v1[3]);
                    *(u32x4*)(z + (size_t)row * ldc + col0 + bj * HALF) = w; }
            }
    }
};
struct EpiResid {
    static constexpr bool PERM = false, AFTER_DRAIN = false;
    const float* xin; float* xout; bf16_t* xb; float* ssq; float coef;
    __device__ __forceinline__ void operator()(const f32x4 (&acc)[2][2][4][2], const Unit& u, int wr, int wc, int fr, int fq) const {
        const int row0 = u.pm * BM + wr * 64 + fr, col0 = u.pn * BM + wc * 32 + 4 * fq;
#pragma unroll
        for (int ai = 0; ai < 2; ++ai)
#pragma unroll
            for (int m = 0; m < 4; ++m) {
                const int row = row0 + ai * HALF + m * 16; const size_t off = (size_t)row * cfg::D + col0; float s = 0.f;
#pragma unroll
                for (int bj = 0; bj < 2; ++bj)
#pragma unroll
                    for (int n = 0; n < 2; ++n) {
                        const f32x4 xi = *(const f32x4*)(xin + off + bj * HALF + n * 16); const f32x4 o = xi + acc[ai][bj][m][n] * coef;
                        *(f32x4*)(xout + off + bj * HALF + n * 16) = o;
                        u32x2 w; w.x = pk2(o[0], o[1]); w.y = pk2(o[2], o[3]); *(u32x2*)(xb + off + bj * HALF + n * 16) = w;
                        s += (o[0] * o[0] + o[1] * o[1]) + (o[2] * o[2] + o[3] * o[3]);
                    }
                s += __shfl_xor(s, 16); s += __shfl_xor(s, 32);
                if (fq == 0) ssq[(size_t)row * 16 + u.pn * 4 + wc] = s;
            }
    }
};
template <class Epi, class Sched, bool STAMP = false>
__device__ __forceinline__ void gemm_phase(PG8_LAS unsigned char* lds, const Gemm g, const Sched& S, const Epi& E, unsigned long long* stamps) {
    int tid_ = threadIdx.x; asm volatile("" : "+v"(tid_)); const int tid = tid_, wid = __builtin_amdgcn_readfirstlane(tid >> 6), lane = tid & 63, wr = wid >> 2, wc = wid & 3, fr = lane & 15, fq = lane >> 4;
    const int K = g.K, nt = K / BK;
    int ts_lo = 0, ts_hi = 0, nts = 0; const unsigned long long rt_entry = STAMP ? (unsigned long long)wall_clock64() : 0ull;
#define PG8_STAMP() do { if (STAMP && wid == 0 && nts < 64) { const unsigned long long _c = (unsigned long long)clock64(); \
        ts_lo = (lane == nts) ? (int)(unsigned)_c : ts_lo; ts_hi = (lane == nts) ? (int)(unsigned)(_c >> 32) : ts_hi; ++nts; } } while (0)
    PG8_STAMP();
    unsigned voffA[2], voffB[2];
#pragma unroll
    for (int i = 0; i < 2; ++i) { int R, C; stage_rc(tid * 16 + i * 8192, R, C); const int Rb = Epi::PERM ? ((R & ~31) + perm32(R & 31)) : R;
        voffA[i] = (unsigned)(R * K + C) * 2u; voffB[i] = (unsigned)(Rb * K + C) * 2u; }
    const size_t kstep = (size_t)(BK * 2);
    const size_t hstep = (size_t)HALF * K * 2;
    const size_t tstep = 2 * hstep;
    const unsigned ldsw = (unsigned)wid * 1024u;
    const int aoff = lds_byte(wr * 64 + fr, fq * 8), boff = lds_byte(wc * 32 + fr, fq * 8);
#define PG8_SA(b, h) (((b) * 2 + (h)) * HTB)
#define PG8_SB(b, h) ((4 + (b) * 2 + (h)) * HTB)
#define PG8_STAGE(bufoff, gbase, voff) do { _Pragma("unroll") for (int _i = 0; _i < 2; ++_i) \
        __builtin_amdgcn_global_load_lds((const unsigned*)((const char*)(gbase) + (voff)[_i]), (PG8_LAS unsigned*)(lds + (bufoff) + ldsw + _i * 8192), 16, 0, 0); } while (0)
#define PG8_LDA(dst, b, h) do { _Pragma("unroll") for (int m = 0; m < 4; ++m) _Pragma("unroll") for (int k = 0; k < 2; ++k) dst[m][k] = *(const PG8_LAS bf16x8*)(lds + PG8_SA(b, h) + aoff + m * 2048 + k * 1024); } while (0)
#define PG8_LDB(dst, b, h) do { _Pragma("unroll") for (int n = 0; n < 2; ++n) _Pragma("unroll") for (int k = 0; k < 2; ++k) dst[n][k] = *(const PG8_LAS bf16x8*)(lds + PG8_SB(b, h) + boff + n * 2048 + k * 1024); } while (0)
#define PG8_MMA(ai, bj, At, Bt) do { __builtin_amdgcn_s_setprio(1); _Pragma("unroll") for (int m = 0; m < 4; ++m) _Pragma("unroll") for (int n = 0; n < 2; ++n) _Pragma("unroll") for (int k = 0; k < 2; ++k) \
        acc[ai][bj][m][n] = __builtin_amdgcn_mfma_f32_16x16x32_bf16(Bt[n][k], At[m][k], acc[ai][bj][m][n], 0, 0, 0); __builtin_amdgcn_s_setprio(0); } while (0)
#define PG8_WAIT_V(n) asm volatile("s_waitcnt vmcnt(" #n ")" ::: "memory")
#define PG8_WAIT_L(n) asm volatile("s_waitcnt lgkmcnt(" #n ")" ::: "memory")
#define PG8_BAR __builtin_amdgcn_s_barrier()
#define PG8_SCHED __builtin_amdgcn_sched_barrier(0)
    Unit cur, nxt; int ui = 0;
    if (!S.next(0, cur)) return;
    f32x4 acc[2][2][4][2];
#pragma unroll
    for (int a = 0; a < 2; ++a)
#pragma unroll
        for (int b = 0; b < 2; ++b)
#pragma unroll
            for (int m = 0; m < 4; ++m)
#pragma unroll
                for (int n = 0; n < 2; ++n) acc[a][b][m][n] = (f32x4){0.f, 0.f, 0.f, 0.f};
    bf16x8 At[4][2], B0[2][2], B1[2][2];
    const char* cA = (const char*)g.A + (size_t)cur.pm * tstep; const char* cB = (const char*)g.Bt + (size_t)cur.pn * tstep;
    S.a_ready(cur);
    PG8_STAGE(PG8_SB(0, 0), cB, voffB); PG8_STAGE(PG8_SA(0, 0), cA, voffA); PG8_STAGE(PG8_SB(0, 1), cB + hstep, voffB); PG8_STAGE(PG8_SA(0, 1), cA + hstep, voffA);
    if (wr == 1) PG8_BAR;
    PG8_WAIT_V(4); PG8_BAR;
    PG8_STAGE(PG8_SB(1, 0), cB + kstep, voffB); PG8_STAGE(PG8_SA(1, 0), cA + kstep, voffA); PG8_STAGE(PG8_SB(1, 1), cB + hstep + kstep, voffB);
    PG8_WAIT_V(6); PG8_BAR;
    PG8_STAMP();
    for (;;) {
        const bool has_next = S.next(ui + 1, nxt);
        const char* nA = has_next ? (const char*)g.A + (size_t)nxt.pm * tstep : cA; const char* nB = has_next ? (const char*)g.Bt + (size_t)nxt.pn * tstep : cB;
        for (int t = 0; t < nt; t += 2) {
            const bool last = (t == nt - 2);
            const char* a1 = cA + (size_t)(t + 1) * kstep;
            const char* a2 = last ? nA : cA + (size_t)(t + 2) * kstep; const char* b2 = last ? nB : cB + (size_t)(t + 2) * kstep;
            const char* a3 = a2 + kstep; const char* b3 = b2 + kstep;
            if (last && has_next) S.a_ready(nxt);
            PG8_LDB(B0, 0, 0); PG8_SCHED; PG8_LDA(At, 0, 0); PG8_STAGE(PG8_SA(1, 1), a1 + hstep, voffA);
            PG8_WAIT_L(8); PG8_BAR; PG8_WAIT_L(0); PG8_MMA(0, 0, At, B0); PG8_BAR; PG8_SCHED;
            PG8_LDB(B1, 0, 1); PG8_STAGE(PG8_SB(0, 0), b2, voffB);
            PG8_BAR; PG8_WAIT_L(0); PG8_MMA(0, 1, At, B1); PG8_BAR;
            PG8_LDA(At, 0, 1); PG8_STAGE(PG8_SA(0, 0), a2, voffA);
            PG8_BAR; PG8_WAIT_L(0); PG8_MMA(1, 0, At, B0); PG8_BAR; PG8_SCHED;
            PG8_STAGE(PG8_SB(0, 1), b2 + hstep, voffB);
            PG8_WAIT_V(6); PG8_BAR; PG8_MMA(1, 1, At, B1); PG8_BAR;
            PG8_LDB(B0, 1, 0); PG8_SCHED; PG8_LDA(At, 1, 0); PG8_STAGE(PG8_SA(0, 1), a2 + hstep, voffA);
            PG8_WAIT_L(8); PG8_BAR; PG8_WAIT_L(0); PG8_MMA(0, 0, At, B0); PG8_BAR; PG8_SCHED;
            PG8_LDB(B1, 1, 1); PG8_STAGE(PG8_SB(1, 0), b3, voffB);
            PG8_BAR; PG8_WAIT_L(0); PG8_MMA(0, 1, At, B1); PG8_BAR;
            PG8_LDA(At, 1, 1); PG8_STAGE(PG8_SA(1, 0), a3, voffA);
            PG8_BAR; PG8_WAIT_L(0); PG8_MMA(1, 0, At, B0); PG8_BAR; PG8_SCHED;
            PG8_STAGE(PG8_SB(1, 1), b3 + hstep, voffB);
            PG8_WAIT_V(6); PG8_BAR; PG8_MMA(1, 1, At, B1); PG8_BAR;
        }
        PG8_STAMP();
        if constexpr (!Epi::AFTER_DRAIN) { E(acc, cur, wr, wc, fr, fq); S.done(cur); }
        PG8_STAMP();
        if (!has_next) break;
#pragma unroll
        for (int a = 0; a < 2; ++a)
#pragma unroll
            for (int b = 0; b < 2; ++b)
#pragma unroll
                for (int m = 0; m < 4; ++m)
#pragma unroll
                    for (int n = 0; n < 2; ++n) acc[a][b][m][n] = (f32x4){0.f, 0.f, 0.f, 0.f};
        cur = nxt; cA = nA; cB = nB; ++ui;
    }
    PG8_WAIT_V(0);
    if (wr == 0) PG8_BAR;
    PG8_BAR;
    if constexpr (Epi::AFTER_DRAIN) { E.fused(acc, cur, wr, wc, fr, fq, lds, wid, lane); S.done(cur); }
    PG8_STAMP();
    if (STAMP && wid == 0) { stamps[lane] = lane < nts ? (((unsigned long long)(unsigned)ts_hi << 32) | (unsigned)ts_lo) : 0ull;
        if (lane == 62) stamps[62] = rt_entry; if (lane == 63) stamps[63] = (unsigned long long)wall_clock64(); }
#undef PG8_STAMP
#undef PG8_SA
#undef PG8_SB
#undef PG8_STAGE
#undef PG8_LDA
#undef PG8_LDB
#undef PG8_MMA
#undef PG8_WAIT_V
#undef PG8_WAIT_L
#undef PG8_BAR
#undef PG8_SCHED
}
}
namespace ph {
using namespace cfg;
typedef LAS char* ldsp;
__device__ __forceinline__ int otid() { int t = threadIdx.x; asm volatile("" : "+v"(t)); return t; }

__device__ __forceinline__ bf16_t* wsb(const Args& a, size_t off) { return (bf16_t*)(a.ws + off); }
__device__ __forceinline__ float* wsf(const Args& a, size_t off) { return (float*)(a.ws + off); }

struct CvtJob { const float* src0; const float* src1; const float* gain; bf16_t* dst; int K, Nsrc, Ndst, mode; };
constexpr int T_GU = 16 * 88, T_DN = 44 * 16, T_WIN = 16 * 40, T_WOUT = 16 * 16, T_CW1 = 32 * 4, T_CW2 = 4 * 1;
constexpr int CVT_TILES = 4 * T_GU + 4 * T_DN + 2 * T_WIN + 2 * T_WOUT + 2 * T_CW1 + 2 * T_CW2;
__device__ __forceinline__ int odd_colmap(int n) { if (n < 800) return n; if (n < 832) return -1; if (n < 2368) return n - 28; if (n < 2372) return 800 + (n - 2368); return -1; }
__device__ __forceinline__ int cvt_job(const Args& a, int tile, CvtJob& J) {
    if (tile < 4 * T_GU) { const int f = tile / T_GU, L = f >> 1, w = f & 1; const size_t o = (size_t)L * D * FF;
        J = CvtJob{a.in[w ? 8 : 3] + o, a.in[w ? 9 : 4] + o, a.in[w ? 7 : 2] + L * D, wsb(a, wsm::WGU + f * wsm::WGU_1), D, FF, NGU, 1}; return tile - f * T_GU; }
    tile -= 4 * T_GU;
    if (tile < 4 * T_DN) { const int f = tile / T_DN, L = f >> 1, w = f & 1; const size_t o = (size_t)L * D * FF;
        J = CvtJob{a.in[w ? 10 : 5] + o, nullptr, nullptr, wsb(a, wsm::WD + f * wsm::WD_1), FF, D, D, 0}; return tile - f * T_DN; }
    tile -= 4 * T_DN;
    if (tile < T_WIN) { J = CvtJob{a.in[11], nullptr, a.in[6], wsb(a, wsm::WIN), D, EV_NSRC, ZLD, 0}; return tile; }
    tile -= T_WIN;
    if (tile < T_WIN) { J = CvtJob{a.in[22], nullptr, a.in[6] + D, wsb(a, wsm::WIN + wsm::WIN_1), D, OD_NSRC, ZLD, 2}; return tile; }
    tile -= T_WIN;
    if (tile < T_WOUT) { J = CvtJob{a.in[21], nullptr, nullptr, wsb(a, wsm::WOUT), D, D, D, 0}; return tile; }
    tile -= T_WOUT;
    if (tile < T_WOUT) { J = CvtJob{a.in[23], nullptr, nullptr, wsb(a, wsm::WOUT + wsm::WOUT_1), D, D, D, 0}; return tile; }
    tile -= T_WOUT;
    if (tile < 2 * T_CW1) { const int kv = tile / T_CW1; J = CvtJob{a.in[kv ? 19 : 16], nullptr, nullptr, wsb(a, wsm::CW1T + kv * wsm::CW1T_1), 2048, 256, 256, 0}; return tile - kv * T_CW1; }
    tile -= 2 * T_CW1;
    { const int kv = tile / T_CW2; J = CvtJob{a.in[kv ? 20 : 17], nullptr, nullptr, wsb(a, wsm::CW2T + kv * wsm::CW2T_1), 256, 64, 64, 0}; return tile - kv * T_CW2; }
}
__device__ __forceinline__ void cvt_tile(const CvtJob& J, int tile, ldsp lds) {
    const int tid = otid(), ntn = J.Ndst >> 6, tk = tile / ntn, tn = tile - tk * ntn, k0 = tk * 64, n0 = tn * 64;
    LAS bf16_t* T = (LAS bf16_t*)lds;
    { const int nn = tid & 63, kq = tid >> 6, n = n0 + nn; const float* src = J.src0; int col;
      if (J.mode == 0) col = n < J.Nsrc ? n : -1;
      else if (J.mode == 1) { col = (n >> 8) * 128 + (n & 127); if ((n >> 7) & 1) src = J.src1; }
      else col = odd_colmap(n);
#pragma unroll
      for (int i = 0; i < 8; ++i) { const int kk = kq + 8 * i, k = k0 + kk; float v = col >= 0 ? src[(size_t)k * J.Nsrc + col] : 0.f; if (J.gain) v *= J.gain[k]; T[nn * 72 + kk] = f2bf(v); } }
    __syncthreads();
    { const int nn = tid >> 3, kc = tid & 7; const u32x4 w = *(const LAS u32x4*)(T + nn * 72 + kc * 8); *(u32x4*)(J.dst + (size_t)(n0 + nn) * J.K + k0 + kc * 8) = w; }
    __syncthreads();
}
__device__ __forceinline__ void sincos_pos(float ang, float& s, float& c) {
    const double k = __builtin_rint((double)ang * 0.15915494309189535); const float r = (float)__builtin_fma(-k, 6.283185307179586, (double)ang);
    s = __sinf(r); c = __cosf(r);
}
__device__ __forceinline__ void prologue(const Args& a, ldsp lds) {
    const int tid = otid(), wid = tid >> 6, lane = tid & 63, G = gridDim.x, wg = blockIdx.x;
    for (int t = wg; t < CVT_TILES; t += G) { CvtJob J; const int lt = cvt_job(a, t, J); cvt_tile(J, lt, lds); }
    { const float* x = a.in[0]; bf16_t* xb = wsb(a, wsm::XB); float* ssq = wsf(a, wsm::SSQ);
      for (int row = wg * 8 + wid; row < M; row += G * 8) {
          float s = 0.f;
#pragma unroll
          for (int i = 0; i < 4; ++i) { const int c = i * 256 + lane * 4; const f32x4 v = *(const f32x4*)(x + (size_t)row * D + c);
              u32x2 w; w.x = pk2(v[0], v[1]); w.y = pk2(v[2], v[3]); *(u32x2*)(xb + (size_t)row * D + c) = w; s += (v[0] * v[0] + v[1] * v[1]) + (v[2] * v[2] + v[3] * v[3]); }
#pragma unroll
          for (int o = 32; o >= 1; o >>= 1) s += __shfl_xor(s, o);
          if (lane < 16) ssq[(size_t)row * 16 + lane] = lane == 0 ? s : 0.f;
      } }
    { const int* pos = (const int*)a.in[1]; float* r16 = wsf(a, wsm::ROPE16); float* r8 = wsf(a, wsm::ROPE8);
      const float inv16[8] = {1.0f, 0.1939227432012558f, 0.03760603070259094f, 0.007292664609849453f, 0.0014142135623842478f, 0.00027424818836152554f, 5.318296098266728e-05f, 1.0313386155758053e-05f};
      for (int i = wg * NTHR + tid; i < M; i += G * NTHR) { const float p = (float)pos[i];
#pragma unroll
          for (int j = 0; j < 8; ++j) { float s, c; sincos_pos(p * inv16[j], s, c); r16[(size_t)i * 16 + j] = c; r16[(size_t)i * 16 + 8 + j] = s;
              if ((j & 1) == 0) { r8[(size_t)i * 8 + (j >> 1)] = c; r8[(size_t)i * 8 + 4 + (j >> 1)] = s; } } } }
    { const float* w = a.in[13]; bf16_t* o = wsb(a, wsm::SGUW);
      for (int i = wg * NTHR + tid; i < 4 * 128 * 128; i += G * NTHR) { const int t = (i >> 7) & 127, s = i & 127; o[i] = f2bf(s <= t ? w[i] : 0.f); } }
    { LAS float* red = (LAS float*)lds;
      for (int u = wg; u < 64; u += G) { const int kv = u >> 5, p = u & 31, c = tid & 255, hf = tid >> 8; const float* pe = a.in[kv ? 18 : 15]; const float* w1 = a.in[kv ? 19 : 16];
          float s = 0.f; for (int i = 0; i < 32; ++i) { const int kk = p * 64 + hf * 32 + i; s += pe[kk] * w1[(size_t)kk * 256 + c]; }
          if (hf) red[c] = s; __syncthreads(); if (!hf) wsf(a, wsm::C1P)[(kv * 32 + p) * 256 + c] = s + red[c]; __syncthreads(); } }
}

__device__ __forceinline__ void final_norm(const Args& a) {
    const int tid = otid(), wid = tid >> 6, lane = tid & 63, G = gridDim.x, wg = blockIdx.x; const float* ssq = wsf(a, wsm::SSQ); const float* g = a.in[24];
    for (int row = wg * 8 + wid; row < M; row += G * 8) { const float rs = rstd_from_ssq(ssq, row);
#pragma unroll
        for (int i = 0; i < 4; ++i) { const int c = i * 256 + lane * 4; float* p = a.out + (size_t)row * D + c; const f32x4 v = *(const f32x4*)p, gv = *(const f32x4*)(g + c); *(f32x4*)p = v * rs * gv; } }
}

__device__ __forceinline__ void rot16(const bf16_t* src, bf16_t* dst, const float* cs) {
    const u32x4 a = *(const u32x4*)src, b = *(const u32x4*)(src + 8); const f32x4 c0 = *(const f32x4*)cs, c1 = *(const f32x4*)(cs + 4), s0 = *(const f32x4*)(cs + 8), s1 = *(const f32x4*)(cs + 12);
    float x1[8], x2[8], c[8], s[8];
#pragma unroll
    for (int i = 0; i < 4; ++i) { x1[2 * i] = bflo(a[i]); x1[2 * i + 1] = bfhi(a[i]); x2[2 * i] = bflo(b[i]); x2[2 * i + 1] = bfhi(b[i]); c[i] = c0[i]; c[4 + i] = c1[i]; s[i] = s0[i]; s[4 + i] = s1[i]; }
    u32x4 oa, ob;
#pragma unroll
    for (int i = 0; i < 4; ++i) { oa[i] = pk2(x1[2 * i] * c[2 * i] - x2[2 * i] * s[2 * i], x1[2 * i + 1] * c[2 * i + 1] - x2[2 * i + 1] * s[2 * i + 1]);
                                  ob[i] = pk2(x2[2 * i] * c[2 * i] + x1[2 * i] * s[2 * i], x2[2 * i + 1] * c[2 * i + 1] + x1[2 * i + 1] * s[2 * i + 1]); }
    *(u32x4*)dst = oa; *(u32x4*)(dst + 8) = ob;
}
__device__ __forceinline__ void rot8(bf16_t* p, const float* cs) {
    const u32x4 a = *(const u32x4*)p; const f32x4 c = *(const f32x4*)cs, s = *(const f32x4*)(cs + 4);
    const float x1[4] = {bflo(a[0]), bfhi(a[0]), bflo(a[1]), bfhi(a[1])}, x2[4] = {bflo(a[2]), bfhi(a[2]), bflo(a[3]), bfhi(a[3])};
    u32x4 o; o[0] = pk2(x1[0] * c[0] - x2[0] * s[0], x1[1] * c[1] - x2[1] * s[1]); o[1] = pk2(x1[2] * c[2] - x2[2] * s[2], x1[3] * c[3] - x2[3] * s[3]);
    o[2] = pk2(x2[0] * c[0] + x1[0] * s[0], x2[1] * c[1] + x1[1] * s[1]); o[3] = pk2(x2[2] * c[2] + x1[2] * s[2], x2[3] * c[3] + x1[3] * s[3]);
    *(u32x4*)p = o;
}
__device__ __forceinline__ void rope_even_unit(const Args& a, int u) {
    bf16_t* z = wsb(a, wsm::ACTZ); bf16_t* qr = wsb(a, wsm::QROT); const float* r16 = wsf(a, wsm::ROPE16);
    for (int it = otid(); it < 32 * 18; it += NTHR) { const int tok = u * 32 + it / 18, sl = it % 18; const float* cs = r16 + (size_t)tok * 16;
        if (sl < 12) { const bf16_t* src = z + (size_t)tok * ZLD + E_Q + sl * 64; bf16_t* dst = qr + (size_t)tok * 768 + sl * 64; rot16(src, dst, cs);
#pragma unroll
            for (int i = 2; i < 8; ++i) *(u32x4*)(dst + 8 * i) = *(const u32x4*)(src + 8 * i); }
        else { bf16_t* p = z + (size_t)tok * ZLD + (sl < 15 ? E_KS + (sl - 12) * 64 : E_KW + (sl - 15) * 64); rot16(p, p, cs); } }
}
__device__ __forceinline__ void rope_odd_unit(const Args& a, int u) {
    bf16_t* z = wsb(a, wsm::ACTZ); const float* r16 = wsf(a, wsm::ROPE16); const float* r8 = wsf(a, wsm::ROPE8);
    for (int it = otid(); it < 32 * 30; it += NTHR) { const int tok = u * 32 + it / 30, sl = it % 30; bf16_t* zr = z + (size_t)tok * ZLD;
        if (sl < 25) { const int col = sl < 8 ? O_QC + sl * 64 : (sl == 8 ? O_KC : (sl < 17 ? O_QD + (sl - 9) * 64 : O_KD + (sl - 17) * 64)); rot16(zr + col, zr + col, r16 + (size_t)tok * 16); }
        else { const int col = sl < 29 ? O_QI + (sl - 25) * 32 : O_KI; rot8(zr + col, r8 + (size_t)tok * 8); } }
}

__device__ __forceinline__ void gmlp_unit(const Args& a, int u, ldsp lds) {
    const int tid = otid(), wid = __builtin_amdgcn_readfirstlane(tid >> 6), lane = tid & 63, fr = lane & 15, fq = lane >> 4;
    const bf16_t* z = wsb(a, wsm::ACTZ); bf16_t* mix = wsb(a, wsm::MIX); const int row0 = u * 128;
    constexpr int PIT = 528;
    ldsp U = lds, V = lds + 128 * PIT;
    { const int s = tid >> 2, qd = tid & 3; const bf16_t* zr = z + (size_t)(row0 + s) * ZLD + qd * 64; const float* gn = a.in[12] + qd * 64;
      float vv[64]; float ss = 0.f;
#pragma unroll
      for (int i = 0; i < 8; ++i) { const u32x4 wu = *(const u32x4*)(zr + 8 * i), wv = *(const u32x4*)(zr + 256 + 8 * i); u32x4 ou;
#pragma unroll
          for (int j = 0; j < 4; ++j) { ou[j] = pk2(gelu_tanh(bflo(wu[j])), gelu_tanh(bfhi(wu[j]))); const float v0 = gelu_tanh(bflo(wv[j])), v1 = gelu_tanh(bfhi(wv[j])); vv[8 * i + 2 * j] = v0; vv[8 * i + 2 * j + 1] = v1; ss += v0 * v0 + v1 * v1; }
          *(LAS u32x4*)(U + s * PIT + qd * 128 + i * 16) = ou; }
      ss += __shfl_xor(ss, 1); ss += __shfl_xor(ss, 2);
      const float rs = __builtin_amdgcn_rsqf(ss * (1.0f / 256.0f) + EPS);
#pragma unroll
      for (int i = 0; i < 8; ++i) { const f32x4 g0 = *(const f32x4*)(gn + 8 * i), g1 = *(const f32x4*)(gn + 8 * i + 4); u32x4 ov;
          ov[0] = pk2(vv[8 * i] * rs * g0[0], vv[8 * i + 1] * rs * g0[1]); ov[1] = pk2(vv[8 * i + 2] * rs * g0[2], vv[8 * i + 3] * rs * g0[3]);
          ov[2] = pk2(vv[8 * i + 4] * rs * g1[0], vv[8 * i + 5] * rs * g1[1]); ov[3] = pk2(vv[8 * i + 6] * rs * g1[2], vv[8 * i + 7] * rs * g1[3]);
          *(LAS u32x4*)(V + s * PIT + qd * 128 + i * 16) = ov; } }
    __syncthreads();
    { const bf16_t* W = wsb(a, wsm::SGUW); const float* bias = a.in[14]; const int nks = (16 * wid + 15) / 32 + 1;
#pragma unroll 1
      for (int g = 0; g < 4; ++g) {
          bf16x8 af[4];
#pragma unroll
          for (int ks = 0; ks < 4; ++ks) af[ks] = *(const bf16x8*)(W + ((size_t)g * 128 + 16 * wid + fr) * 128 + 32 * ks + 8 * fq);
#pragma unroll
          for (int dt = 0; dt < 4; ++dt) { f32x4 acc = {0.f, 0.f, 0.f, 0.f}; const int d = g * 64 + dt * 16;
#pragma unroll
              for (int ks = 0; ks < 4; ++ks) if (ks < nks) { ldsp vp = V + (32 * ks + 8 * fq + (fr >> 2)) * PIT + (d + 4 * (fr & 3)) * 2; const s16x4 lo = tr16((const char*)vp), hi = tr16((const char*)(vp + 4 * PIT));
                  const bf16x8 bfr = {lo[0], lo[1], lo[2], lo[3], hi[0], hi[1], hi[2], hi[3]}; acc = MFMA16(af[ks], bfr, acc); }
#pragma unroll
              for (int i = 0; i < 4; ++i) { const int t = 16 * wid + 4 * fq + i; const float uu = bf2f(*(const LAS bf16_t*)(U + t * PIT + (d + fr) * 2)); mix[(size_t)(row0 + t) * 1024 + d + fr] = f2bf(uu * (acc[i] + bias[g * 128 + t])); } }
      } }
    __syncthreads();
}

__device__ __forceinline__ void compress_unit(const Args& a, int u, ldsp lds) {
    const int tid = otid(), wid = __builtin_amdgcn_readfirstlane(tid >> 6), lane = tid & 63, fr = lane & 15, fq = lane >> 4;
    const int nt = u & 7, g = (u >> 3) % 3, b = ((u >> 3) / 3) & 15, kv = (u >> 3) / 48;
    const bf16_t* z = wsb(a, wsm::ACTZ); const bf16_t* w1t = wsb(a, wsm::CW1T + kv * wsm::CW1T_1); const bf16_t* w2t = wsb(a, wsm::CW2T + kv * wsm::CW2T_1);
    LAS float* c1 = (LAS float*)lds; ldsp Hs = lds + 1024; constexpr int PIT = 528;
    if (tid < 256) { const float* p = wsf(a, wsm::C1P) + (size_t)kv * 32 * 256 + tid; float s = 0.f;
#pragma unroll 8
        for (int i = 0; i < 32; ++i) s += p[i * 256]; c1[tid] = s; }
    __syncthreads();
    int n = nt * 16 + fr; if (n > 126) n = 126;
    const bf16_t* ap = z + ((size_t)b * S + 16 * n) * ZLD + (kv ? E_VC : E_KC) + g * 64 + 8 * fq;
    const bf16_t* bp0 = w1t + (size_t)(32 * wid + fr) * 2048 + 8 * fq; const bf16_t* bp1 = bp0 + 16 * 2048;
    f32x4 acc0 = {0.f, 0.f, 0.f, 0.f}, acc1 = {0.f, 0.f, 0.f, 0.f};
#pragma unroll 4
    for (int st = 0; st < 64; ++st) { const int l = st >> 1, d0 = (st & 1) * 32;
        const bf16x8 af = *(const bf16x8*)(ap + (size_t)l * ZLD + d0), b0 = *(const bf16x8*)(bp0 + st * 32), b1 = *(const bf16x8*)(bp1 + st * 32);
        acc0 = MFMA16(af, b0, acc0); acc1 = MFMA16(af, b1, acc1); }
#pragma unroll
    for (int i = 0; i < 4; ++i) { const int r = 4 * fq + i, c0 = 32 * wid + fr;
        *(LAS bf16_t*)(Hs + r * PIT + c0 * 2) = f2bf(gelu_tanh(acc0[i] + c1[c0])); *(LAS bf16_t*)(Hs + r * PIT + (c0 + 16) * 2) = f2bf(gelu_tanh(acc1[i] + c1[c0 + 16])); }
    __syncthreads();
    if (wid < 4) { f32x4 acc = {0.f, 0.f, 0.f, 0.f};
#pragma unroll
        for (int ks = 0; ks < 8; ++ks) { const bf16x8 af = *(const LAS bf16x8*)(Hs + fr * PIT + (32 * ks + 8 * fq) * 2), bfr = *(const bf16x8*)(w2t + (size_t)(16 * wid + fr) * 256 + 32 * ks + 8 * fq); acc = MFMA16(af, bfr, acc); }
        bf16_t* o = wsb(a, kv ? wsm::VCMP : wsm::KCMP) + ((size_t)(b * 3 + g) * 128) * 64;
#pragma unroll
        for (int i = 0; i < 4; ++i) { const int nn = nt * 16 + 4 * fq + i; o[(size_t)nn * 64 + 16 * wid + fr] = nn > 126 ? (bf16_t)0 : f2bf(acc[i]); } }
    __syncthreads();
}

struct AttnAcc { f32x16 o0, o1; float m, l; };
__device__ __forceinline__ void acc_init(AttnAcc& A) {
#pragma unroll
    for (int r = 0; r < 16; ++r) { A.o0[r] = 0.f; A.o1[r] = 0.f; }
    A.m = -1e30f; A.l = 0.f; }
__device__ __forceinline__ void stage_kv(const bf16_t* Kt, int ldk, const bf16_t* Vt, int ldv, ldsp slot, int wid, int lane) {
    const bf16_t* ks = Kt + (size_t)lane * ldk + wid * 8;
    const bf16_t* vs = Vt + (size_t)(16 * (wid & 3) + (lane >> 2)) * ldv + (wid >> 2) * 32 + (lane & 3) * 8;
    __builtin_amdgcn_global_load_lds((const unsigned*)ks, (LAS unsigned*)(slot + wid * 1024), 16, 0, 0);
    __builtin_amdgcn_global_load_lds((const unsigned*)vs, (LAS unsigned*)(slot + 8192 + wid * 1024), 16, 0, 0);
}
__device__ __forceinline__ void load_kfrags(bf16x8 (&kf)[8], ldsp slot, int lane) {
    ldsp kp = slot + (lane >> 5) * 1024 + (lane & 31) * 16;
#pragma unroll
    for (int d0 = 0; d0 < 4; ++d0) { kf[2 * d0] = *(const LAS bf16x8*)(kp + d0 * 2048); kf[2 * d0 + 1] = *(const LAS bf16x8*)(kp + d0 * 2048 + 512); }
}
__device__ __forceinline__ void pv_tile(f32x16& o0, f32x16& o1, const f32x16& p0, const f32x16& p1, ldsp slot, int lane) {
    const int hi = lane >> 5;
    u32x4 pw[4];
#pragma unroll
    for (int i = 0; i < 4; ++i) { pw[0][i] = pk2(p0[2 * i], p0[2 * i + 1]); pw[1][i] = pk2(p0[8 + 2 * i], p0[9 + 2 * i]); pw[2][i] = pk2(p1[2 * i], p1[2 * i + 1]); pw[3][i] = pk2(p1[8 + 2 * i], p1[9 + 2 * i]); }
    ldsp vp = slot + 8192 + ((lane >> 4) & 1) * 32 + (lane & 3) * 8 + (4 * hi + ((lane & 15) >> 2)) * 64;
#pragma unroll
    for (int s = 0; s < 4; ++s) { const bf16x8 pf = __builtin_bit_cast(bf16x8, pw[s]);
        { const s16x4 lo = tr16((const char*)(vp + s * 1024)), h4 = tr16((const char*)(vp + s * 1024 + 512)); const bf16x8 vf = {lo[0], lo[1], lo[2], lo[3], h4[0], h4[1], h4[2], h4[3]}; o0 = MFMA32(vf, pf, o0); }
        { const s16x4 lo = tr16((const char*)(vp + 4096 + s * 1024)), h4 = tr16((const char*)(vp + 4096 + s * 1024 + 512)); const bf16x8 vf = {lo[0], lo[1], lo[2], lo[3], h4[0], h4[1], h4[2], h4[3]}; o1 = MFMA32(vf, pf, o1); } }
}
template <class MF> __device__ __forceinline__ void attn_tile(AttnAcc& A, const bf16x8 (&qr)[4], ldsp slot, int t, const MF& mf, bool masked, int lane) {
    const int hi = lane >> 5;
    bf16x8 kf[8]; load_kfrags(kf, slot, lane);
    f32x16 c0, c1;
#pragma unroll
    for (int r = 0; r < 16; ++r) { c0[r] = 0.f; c1[r] = 0.f; }
#pragma unroll
    for (int d0 = 0; d0 < 4; ++d0) { c0 = MFMA32(kf[2 * d0], qr[d0], c0); c1 = MFMA32(kf[2 * d0 + 1], qr[d0], c1); }
    if (masked) {
#pragma unroll
        for (int r = 0; r < 16; ++r) { const int k0 = crow(r, hi); c0[r] = mf.ok(t, k0) ? c0[r] * C2 : -INFINITY; c1[r] = mf.ok(t, k0 + 32) ? c1[r] * C2 : -INFINITY; }
    } else {
#pragma unroll
        for (int r = 0; r < 16; ++r) { c0[r] *= C2; c1[r] *= C2; }
    }
    float rm = __builtin_fmaxf(c0[0], c1[0]);
#pragma unroll
    for (int r = 1; r < 16; ++r) rm = __builtin_fmaxf(rm, __builtin_fmaxf(c0[r], c1[r]));
    rm = swap32_max(rm);
    const float mn = __builtin_fmaxf(A.m, rm), alpha = __builtin_amdgcn_exp2f(A.m - mn); A.m = mn;
    float sum = 0.f;
#pragma unroll
    for (int r = 0; r < 16; ++r) { c0[r] = __builtin_amdgcn_exp2f(c0[r] - mn); c1[r] = __builtin_amdgcn_exp2f(c1[r] - mn); sum += c0[r] + c1[r]; }
    A.l = A.l * alpha + sum;
#pragma unroll
    for (int r = 0; r < 16; ++r) { A.o0[r] *= alpha; A.o1[r] *= alpha; }
    pv_tile(A.o0, A.o1, c0, c1, slot, lane);
}
template <class MF> __device__ __forceinline__ void attn_run(AttnAcc& A, const bf16x8 (&qr)[4], const bf16_t* K, int ldk, const bf16_t* V, int ldv, int tb, int te, MF& mf, ldsp kv, int wid, int lane) {
    if (tb >= te) return;
    stage_kv(K + (size_t)tb * 64 * ldk, ldk, V + (size_t)tb * 64 * ldv, ldv, kv, wid, lane);
    for (int t = tb; t < te; ++t) {
        ldsp cur = kv + ((t - tb) & 1) * 16384, nxt = kv + (((t - tb) & 1) ^ 1) * 16384;
        asm volatile("s_waitcnt vmcnt(0)" ::: "memory"); __syncthreads();
        if (t + 1 < te) stage_kv(K + (size_t)(t + 1) * 64 * ldk, ldk, V + (size_t)(t + 1) * 64 * ldv, ldv, nxt, wid, lane);
        const int kd = mf.prep(t);
        if (kd) attn_tile(A, qr, cur, t, mf, kd == 2, lane);
    }
    __syncthreads();
}
__device__ __forceinline__ float acc_inv(const AttnAcc& A) { const float l = swap32_sum(A.l); return l > 0.f ? __builtin_amdgcn_rcpf(l) : 0.f; }
__device__ __forceinline__ void store_rows(bf16_t* dst  , const f32x16& o0, const f32x16& o1, float sc, int hi) {
#pragma unroll
    for (int gq = 0; gq < 4; ++gq) { u32x2 w0, w1; w0.x = pk2(o0[4 * gq] * sc, o0[4 * gq + 1] * sc); w0.y = pk2(o0[4 * gq + 2] * sc, o0[4 * gq + 3] * sc); w1.x = pk2(o1[4 * gq] * sc, o1[4 * gq + 1] * sc); w1.y = pk2(o1[4 * gq + 2] * sc, o1[4 * gq + 3] * sc);
        *(u32x2*)(dst + 8 * gq + 4 * hi) = w0; *(u32x2*)(dst + 32 + 8 * gq + 4 * hi) = w1; }
}

struct SlcMF { unsigned sel; int jq, trel;
    __device__ __forceinline__ int prep(int t) const { const bool bit = (sel >> t) & 1u; if (!__any(bit)) return 0; return (t < jq && __all(bit)) ? 1 : 2; }
    __device__ __forceinline__ bool ok(int t, int kr) const { return ((sel >> t) & 1u) && (t < jq || kr <= trel); } };
struct WinMF { int jq, trel;
    __device__ __forceinline__ int prep(int t) const { return (t == jq || t == jq - 8) ? 2 : 1; }
    __device__ __forceinline__ bool ok(int t, int kr) const { return t == jq ? kr <= trel : (t == jq - 8 ? kr > trel : true); } };
__device__ __forceinline__ void nsa_unit(const Args& a, int b, int g, int jq, ldsp lds) {
    const int tid = otid(), wid = __builtin_amdgcn_readfirstlane(tid >> 6), lane = tid & 63, r32 = lane & 31, hi = lane >> 5;
    const int ql = r32 >> 2, hr = r32 & 3, trel = wid * 8 + ql, tok = jq * 64 + trel, h = 4 * g + hr; const size_t row = (size_t)b * S + tok;
    const bf16_t* z = wsb(a, wsm::ACTZ); const bf16_t* qrot = wsb(a, wsm::QROT); const bf16_t* zb = z + (size_t)b * S * ZLD;
    ldsp kv = lds; LAS float* psum = (LAS float*)(lds + 32768) + wid * 1024; LAS float* impw = (LAS float*)(lds + 65536) + wid * 256;
    float gate[3];
#pragma unroll
    for (int i = 0; i < 3; ++i) gate[i] = sigmoidf_(bf2f(z[row * ZLD + E_GL + h * 3 + i]));
    f32x16 out0, out1; unsigned sel;
    {
        const bf16_t* Kc = wsb(a, wsm::KCMP) + (size_t)(b * 3 + g) * 128 * 64; const bf16_t* Vc = wsb(a, wsm::VCMP) + (size_t)(b * 3 + g) * 128 * 64;
        stage_kv(Kc, 64, Vc, 64, kv, wid, lane); stage_kv(Kc + 64 * 64, 64, Vc + 64 * 64, 64, kv + 16384, wid, lane);
        asm volatile("s_waitcnt vmcnt(0)" ::: "memory"); __syncthreads();
        f32x16 c[4];
        bf16x8 qn[4];
#pragma unroll
        for (int d0 = 0; d0 < 4; ++d0) qn[d0] = *(const bf16x8*)(z + row * ZLD + E_Q + h * 64 + 16 * d0 + 8 * hi);
#pragma unroll
        for (int tt = 0; tt < 2; ++tt) { bf16x8 kf[8]; load_kfrags(kf, kv + tt * 16384, lane);
#pragma unroll
            for (int r = 0; r < 16; ++r) { c[2 * tt][r] = 0.f; c[2 * tt + 1][r] = 0.f; }
#pragma unroll
            for (int d0 = 0; d0 < 4; ++d0) { c[2 * tt] = MFMA32(kf[2 * d0], qn[d0], c[2 * tt]); c[2 * tt + 1] = MFMA32(kf[2 * d0 + 1], qn[d0], c[2 * tt + 1]); } }
        float rm = -1e30f;
#pragma unroll
        for (int q = 0; q < 4; ++q)
#pragma unroll
            for (int r = 0; r < 16; ++r) { const int n = 32 * q + crow(r, hi); const float v = (16 * n + 31 <= tok) ? c[q][r] * C2 : -INFINITY; c[q][r] = v; rm = __builtin_fmaxf(rm, v); }
        rm = swap32_max(rm); float sum = 0.f;
#pragma unroll
        for (int q = 0; q < 4; ++q)
#pragma unroll
            for (int r = 0; r < 16; ++r) { const float p = __builtin_amdgcn_exp2f(c[q][r] - rm); c[q][r] = p; sum += p; }
        sum = swap32_sum(sum); const float inv = sum > 0.f ? __builtin_amdgcn_rcpf(sum) : 0.f;
#pragma unroll
        for (int q = 0; q < 4; ++q)
#pragma unroll
            for (int r = 0; r < 16; ++r) c[q][r] *= inv;
#pragma unroll
        for (int r = 0; r < 16; ++r) { out0[r] = 0.f; out1[r] = 0.f; }
        pv_tile(out0, out1, c[0], c[1], kv, lane); pv_tile(out0, out1, c[2], c[3], kv + 16384, lane);
#pragma unroll
        for (int r = 0; r < 16; ++r) { out0[r] *= gate[0]; out1[r] *= gate[0]; }
#pragma unroll
        for (int q = 0; q < 4; ++q)
#pragma unroll
            for (int r = 0; r < 16; ++r) { float v = c[q][r]; v += __shfl_xor(v, 1); v += __shfl_xor(v, 2); if (hr == 0) psum[(32 * q + crow(r, hi)) * 8 + ql] = v; }
        asm volatile("s_waitcnt lgkmcnt(0)" ::: "memory");
        { const int q = lane & 7, jj = lane >> 3; float val[4];
#pragma unroll
          for (int k = 0; k < 4; ++k) { const int j = jj + 8 * k; float s = 0.f;
#pragma unroll
              for (int n = 4 * j - 1; n <= 4 * j + 3; ++n) if (n >= 0) s += psum[n * 8 + q];
              const bool adm = j <= jq, forced = (j == 0) || (j == jq); val[k] = adm ? (forced ? 1e4f : s) : -1e30f; impw[q * 32 + j] = val[k]; }
          asm volatile("s_waitcnt lgkmcnt(0)" ::: "memory");
          int rank[4] = {0, 0, 0, 0};
#pragma unroll
          for (int j4 = 0; j4 < 8; ++j4) { const f32x4 o = *(const LAS f32x4*)(impw + q * 32 + 4 * j4);
#pragma unroll
              for (int e = 0; e < 4; ++e) { const int jo = 4 * j4 + e;
#pragma unroll
                  for (int k = 0; k < 4; ++k) { const int j = jj + 8 * k; rank[k] += (o[e] > val[k] || (o[e] == val[k] && jo < j)) ? 1 : 0; } } }
          unsigned bits = 0u;
#pragma unroll
          for (int k = 0; k < 4; ++k) { const int j = jj + 8 * k; if (j <= jq && rank[k] < 8) bits |= 1u << j; }
          bits |= __shfl_xor(bits, 8); bits |= __shfl_xor(bits, 16); bits |= __shfl_xor(bits, 32);
          sel = __shfl(bits, ql); }
        __syncthreads();
    }
    bf16x8 qr[4];
#pragma unroll
    for (int d0 = 0; d0 < 4; ++d0) qr[d0] = *(const bf16x8*)(qrot + row * 768 + h * 64 + 16 * d0 + 8 * hi);
    { AttnAcc A; acc_init(A); SlcMF mf{sel, jq, trel};
      attn_run(A, qr, zb + E_KS + g * 64, ZLD, zb + E_VS + g * 64, ZLD, 0, jq + 1, mf, kv, wid, lane);
      const float sc = acc_inv(A) * gate[1];
#pragma unroll
      for (int r = 0; r < 16; ++r) { out0[r] += A.o0[r] * sc; out1[r] += A.o1[r] * sc; } }
    { AttnAcc A; acc_init(A); WinMF mf{jq, trel};
      attn_run(A, qr, zb + E_KW + g * 64, ZLD, zb + E_VW + g * 64, ZLD, jq >= 8 ? jq - 8 : 0, jq + 1, mf, kv, wid, lane);
      const float sc = acc_inv(A) * gate[2];
#pragma unroll
      for (int r = 0; r < 16; ++r) { out0[r] += A.o0[r] * sc; out1[r] += A.o1[r] * sc; } }
    store_rows(wsb(a, wsm::MIX) + row * 1024 + 256 + h * 64, out0, out1, 1.0f, hi);
}

__device__ __forceinline__ unsigned order_key(float f) { unsigned u = __float_as_uint(f); if ((u << 1) == 0u) u = 0u; return u ^ ((u >> 31) ? 0xFFFFFFFFu : 0x80000000u); }
__device__ __forceinline__ void dsa_select_unit(const Args& a, int b, int qt, ldsp lds) {
    const int tid = otid(), wid = __builtin_amdgcn_readfirstlane(tid >> 6), lane = tid & 63, fr = lane & 15, fq = lane >> 4;
    const bf16_t* zb = wsb(a, wsm::ACTZ) + (size_t)b * S * ZLD; const int t0 = qt * 16, t = t0 + fr; const int nW = (t0 + 15) / 32 + 1;
    LAS unsigned* cnts = (LAS unsigned*)lds;
    bf16x8 bq[4]; float wq[4];
#pragma unroll
    for (int h = 0; h < 4; ++h) { bq[h] = *(const bf16x8*)(zb + (size_t)t * ZLD + O_QI + h * 32 + 8 * fq); wq[h] = bf2f(zb[(size_t)t * ZLD + O_WI + h]); }
    unsigned U[8][8];
#pragma unroll
    for (int k = 0; k < 8; ++k) { const int word = wid + 8 * k;
        if (word < nW) {
#pragma unroll
            for (int hf = 0; hf < 2; ++hf) { const int kb = 32 * word + 16 * hf; const bf16x8 af = *(const bf16x8*)(zb + (size_t)(kb + fr) * ZLD + O_KI + 8 * fq);
                f32x4 sc = {0.f, 0.f, 0.f, 0.f};
#pragma unroll
                for (int h = 0; h < 4; ++h) { const f32x4 zero = {0.f, 0.f, 0.f, 0.f}; const f32x4 cc = MFMA16(af, bq[h], zero);
#pragma unroll
                    for (int i = 0; i < 4; ++i) sc[i] += wq[h] * __builtin_fmaxf(cc[i], 0.f); }
#pragma unroll
                for (int i = 0; i < 4; ++i) { const int key = kb + 4 * fq + i; U[k][4 * hf + i] = key <= t ? order_key(sc[i]) : 0u; } }
        } else {
#pragma unroll
            for (int i = 0; i < 8; ++i) U[k][i] = 0u;
        } }
#define DSA_COUNT2(EXPR1, EXPR2, PAR, OUT1, OUT2) do { unsigned c1_ = 0u, c2_ = 0u; \
        _Pragma("unroll") for (int k = 0; k < 8; ++k) _Pragma("unroll") for (int i = 0; i < 8; ++i) { const unsigned u = U[k][i]; const int key = 32 * (wid + 8 * k) + 16 * (i >> 2) + 4 * fq + (i & 3); (void)key; c1_ += (EXPR1) ? 1u : 0u; c2_ += (EXPR2) ? 1u : 0u; } \
        c1_ += __shfl_xor(c1_, 16); c1_ += __shfl_xor(c1_, 32); c2_ += __shfl_xor(c2_, 16); c2_ += __shfl_xor(c2_, 32); \
        if (fq == 0) { cnts[(PAR) * 256 + wid * 32 + fr] = c1_; cnts[(PAR) * 256 + wid * 32 + 16 + fr] = c2_; } \
        asm volatile("s_waitcnt lgkmcnt(0)" ::: "memory"); __syncthreads(); \
        OUT1 = 0u; OUT2 = 0u; _Pragma("unroll") for (int w = 0; w < 8; ++w) { OUT1 += cnts[(PAR) * 256 + w * 32 + fr]; OUT2 += cnts[(PAR) * 256 + w * 32 + 16 + fr]; } } while (0)
    unsigned T = 0u;
    for (int bit = 31; bit >= 0; --bit) { const unsigned cand = T | (1u << bit); unsigned n1, n2; DSA_COUNT2(u >= cand, false, bit & 1, n1, n2); (void)n2; if (n1 >= 256u) T = cand; }
    unsigned cg, ce; DSA_COUNT2(u > T, u == T, 1, cg, ce);
    const unsigned budget = 256u - cg;
    int I = 2047;
    const bool over = (T != 0u) && (ce > budget);
    { __syncthreads(); LAS unsigned* flag = cnts + 600; if (tid == 0) *flag = 0u; __syncthreads(); if (over) *flag = 1u; __syncthreads();
      if (*flag) { int lo = 0;
          for (int bit = 10; bit >= 0; --bit) { const int cand = lo | (1 << bit); unsigned n1, n2; DSA_COUNT2(u == T && key < cand, false, bit & 1, n1, n2); (void)n2; if (n1 < budget) lo = cand; }
          if (over) I = lo; }
      __syncthreads(); }
#undef DSA_COUNT2
    unsigned* mw = (unsigned*)(a.ws + wsm::DMASK) + ((size_t)b * S + t) * 64;
#pragma unroll
    for (int k = 0; k < 8; ++k) { unsigned bits = 0u;
#pragma unroll
        for (int i = 0; i < 8; ++i) { const unsigned u = U[k][i]; const int key = 32 * (wid + 8 * k) + 16 * (i >> 2) + 4 * fq + (i & 3); const bool s = (key <= t) && (u > T || (u == T && key <= I)); bits |= s ? (1u << (16 * (i >> 2) + 4 * fq + (i & 3))) : 0u; }
        bits |= __shfl_xor(bits, 16); bits |= __shfl_xor(bits, 32);
        if (fq == 0) mw[wid + 8 * k] = bits; }
    __syncthreads();
}
__device__ __forceinline__ void kmean_unit(const Args& a, int u) {
    const int b = u >> 3, j = u & 7, c = otid(); const bf16_t* p = wsb(a, wsm::ACTZ) + ((size_t)b * S + j * 256) * ZLD + O_KD + c; float s = 0.f;
#pragma unroll 8
    for (int r = 0; r < 256; ++r) s += bf2f(p[(size_t)r * ZLD]);
    wsf(a, wsm::KMEAN)[((size_t)(b * 8 + (c >> 6)) * 8 + j) * 64 + (c & 63)] = s * (1.0f / 256.0f);
}

struct DsaMF { const unsigned* mw; unsigned w0, w1;
    __device__ __forceinline__ int prep(int t) { w0 = mw[2 * t]; w1 = mw[2 * t + 1]; return __any((w0 | w1) != 0u) ? 2 : 0; }
    __device__ __forceinline__ bool ok(int, int kr) const { return (((kr & 32) ? w1 : w0) >> (kr & 31)) & 1u; } };
__device__ __forceinline__ void dsa_attn_unit(const Args& a, int b, int qt, ldsp lds) {
    const int tid = otid(), wid = __builtin_amdgcn_readfirstlane(tid >> 6), lane = tid & 63, r32 = lane & 31, hi = lane >> 5;
    const int q0 = qt * 32, tok = q0 + r32; const size_t row = (size_t)b * S + tok; const bf16_t* z = wsb(a, wsm::ACTZ); const bf16_t* zb = z + (size_t)b * S * ZLD;
    bf16x8 qr[4];
#pragma unroll
    for (int d0 = 0; d0 < 4; ++d0) qr[d0] = *(const bf16x8*)(z + row * ZLD + O_QC + wid * 64 + 16 * d0 + 8 * hi);
    AttnAcc A; acc_init(A); DsaMF mf{(const unsigned*)(a.ws + wsm::DMASK) + row * 64, 0u, 0u};
    attn_run(A, qr, zb + O_KC, ZLD, zb + O_VC, ZLD, 0, q0 / 64 + 1, mf, lds, wid, lane);
    store_rows(wsb(a, wsm::MIX) + row * 1024 + wid * 64, A.o0, A.o1, acc_inv(A), hi);
}

struct MobaMF { unsigned sel; int own, wq, r32;
    __device__ __forceinline__ int prep(int t) const { const int jb = t >> 2;
        if (jb < own) { const bool bit = (sel >> jb) & 1u; if (!__any(bit)) return 0; return __all(bit) ? 1 : 2; }
        const int k0 = 64 * (t - 4 * own); if (k0 > wq + 31) return 0; return (k0 + 63 <= wq) ? 1 : 2; }
    __device__ __forceinline__ bool ok(int t, int kr) const { const int jb = t >> 2; return jb < own ? ((sel >> jb) & 1u) : (64 * (t - 4 * own) + kr <= wq + r32); } };
__device__ __forceinline__ void moba_unit(const Args& a, int b, int h, int own, ldsp lds) {
    const int tid = otid(), wid = __builtin_amdgcn_readfirstlane(tid >> 6), lane = tid & 63, r32 = lane & 31, hi = lane >> 5;
    const int tok = own * 256 + wid * 32 + r32; const size_t row = (size_t)b * S + tok; const bf16_t* z = wsb(a, wsm::ACTZ); const bf16_t* zb = z + (size_t)b * S * ZLD;
    bf16x8 qr[4];
#pragma unroll
    for (int d0 = 0; d0 < 4; ++d0) qr[d0] = *(const bf16x8*)(z + row * ZLD + O_QD + h * 64 + 16 * d0 + 8 * hi);
    float gt[7]; const float* km = wsf(a, wsm::KMEAN) + (size_t)(b * 8 + h) * 8 * 64;
#pragma unroll
    for (int j = 0; j < 7; ++j) { float s = 0.f;
        if (j < own) {
#pragma unroll
            for (int d0 = 0; d0 < 4; ++d0) { const f32x4 k0 = *(const f32x4*)(km + j * 64 + 16 * d0 + 8 * hi), k1 = *(const f32x4*)(km + j * 64 + 16 * d0 + 8 * hi + 4); const u32x4 qw = __builtin_bit_cast(u32x4, qr[d0]);
                s += bflo(qw[0]) * k0[0] + bfhi(qw[0]) * k0[1] + bflo(qw[1]) * k0[2] + bfhi(qw[1]) * k0[3] + bflo(qw[2]) * k1[0] + bfhi(qw[2]) * k1[1] + bflo(qw[3]) * k1[2] + bfhi(qw[3]) * k1[3]; }
            s = swap32_sum(s); }
        gt[j] = s; }
    unsigned sel = 0u;
#pragma unroll
    for (int j = 0; j < 7; ++j) { int rank = 0;
#pragma unroll
        for (int j2 = 0; j2 < 7; ++j2) rank += (j2 < own && j2 != j && (gt[j2] > gt[j] || (gt[j2] == gt[j] && j2 < j))) ? 1 : 0;
        if (j < own && rank < 3) sel |= 1u << j; }
    AttnAcc A; acc_init(A); MobaMF mf{sel, own, wid * 32, r32};
    attn_run(A, qr, zb + O_KD + h * 64, ZLD, zb + O_VD + h * 64, ZLD, 0, 4 * own + 4, mf, lds, wid, lane);
    store_rows(wsb(a, wsm::MIX) + row * 1024 + 512 + h * 64, A.o0, A.o1, acc_inv(A), hi);
}
}

#define XB_TMO      128
#define XB_XCNT(j)  (256  + 64 * (j))
#define XB_XSUB(j)  (1280 + 64 * (j))
#define XB_XGEN(j)  (2304 + 64 * (j))
#define XB_TOP      3328
#define XB_TOPGEN   3392
#define XCD_BAR_WORDS 3456
#define XB_SPIN_CAP (1u << 18)
#define LAS __attribute__((address_space(3)))

__device__ __forceinline__ unsigned xb_ld(unsigned* p)              { return __hip_atomic_load(p, __ATOMIC_RELAXED, __HIP_MEMORY_SCOPE_AGENT); }
__device__ __forceinline__ unsigned xb_add(unsigned* p, unsigned v) { return __hip_atomic_fetch_add(p, v, __ATOMIC_RELAXED, __HIP_MEMORY_SCOPE_AGENT); }
__device__ __forceinline__ unsigned xb_xcc_id() { return (unsigned)__builtin_amdgcn_s_getreg((3 << 11) | 20) & 0xFu; }
#define XB_SPIN(cond, bar) do { unsigned _sp = 0; while (cond) { __builtin_amdgcn_s_sleep(1); \
    if ((++_sp & 255u) == 0u) { if (xb_ld(&(bar)[XB_TMO])) break; if (_sp > XB_SPIN_CAP) { atomicAdd(&(bar)[XB_TMO], 1u); break; } } } } while (0)

struct XcdBarrier {
    unsigned* bar; unsigned x;
    volatile LAS unsigned* st;
};

__device__ __forceinline__ XcdBarrier xcd_barrier_post(unsigned* bar, volatile LAS unsigned* st) {
    XcdBarrier b; b.bar = bar; b.x = xb_xcc_id(); b.st = st;
    if (threadIdx.x == 0) (void)xb_add(&bar[XB_XCNT(b.x)], 1u);
    return b;
}
__device__ __forceinline__ void xcd_barrier_complete(unsigned* bar, unsigned x, unsigned& nloc, unsigned& nx) {
    const unsigned G = gridDim.x * gridDim.y * gridDim.z;
    unsigned sum, cnt, mine, sp = 0u;
    for (;;) {
        sum = 0u; cnt = 0u; mine = 0u;
#pragma unroll
        for (unsigned j = 0; j < 16; ++j) { const unsigned c = xb_ld(&bar[XB_XCNT(j)]); sum += c; cnt += (c > 0u) ? 1u : 0u; mine = (j == x) ? c : mine; }
        if (sum == G) break;
        __builtin_amdgcn_s_sleep(1);
        if ((++sp & 255u) == 0u) { if (xb_ld(&bar[XB_TMO])) break; if (sp > XB_SPIN_CAP) { atomicAdd(&bar[XB_TMO], 1u); break; } }
    }
    nloc = mine > 0u ? mine : 1u; nx = cnt > 0u ? cnt : 1u;
}

__device__ __forceinline__ void xcd_barrier(const XcdBarrier& b) {
    asm volatile("s_waitcnt vmcnt(0)" ::: "memory");
    __syncthreads();
    if (threadIdx.x == 0) {
        unsigned* bar = b.bar;
        __builtin_amdgcn_s_waitcnt(0);
        unsigned nloc = b.st[0], nx = b.st[1];
        if (nloc == 0u) { xcd_barrier_complete(bar, b.x, nloc, nx); b.st[0] = nloc; b.st[1] = nx; }
        const unsigned old = xb_add(&bar[XB_XSUB(b.x)], 1u);
        const unsigned gen = old / nloc;
        if (old + 1u == (gen + 1u) * nloc) {
            __builtin_amdgcn_fence(__ATOMIC_RELEASE, "agent");
            asm volatile("s_waitcnt vmcnt(0)" ::: "memory");
            const unsigned og = xb_add(&bar[XB_TOP], 1u);
            const unsigned tg = og / nx;
            if (og + 1u == (tg + 1u) * nx) xb_add(&bar[XB_TOPGEN], 1u);
            else XB_SPIN(xb_ld(&bar[XB_TOPGEN]) == tg, bar);
            __builtin_amdgcn_fence(__ATOMIC_ACQUIRE, "agent");
            xb_add(&bar[XB_XGEN(b.x)], 1u);
            asm volatile("s_waitcnt vmcnt(0)" ::: "memory");
        } else {
            XB_SPIN(xb_ld(&bar[XB_XGEN(b.x)]) == gen, bar);
            __builtin_amdgcn_fence(__ATOMIC_ACQUIRE, "agent");
            asm volatile("s_waitcnt vmcnt(0)" ::: "memory");
        }
    }
    __syncthreads();
}
#define MK_ONE_LAUNCH 0
#ifndef MK_ONE_LAUNCH
#define MK_ONE_LAUNCH 1
#endif
constexpr int N_PHASES = 19;
__device__ __forceinline__ int bal16(int x) { const int k = x >> 4, c = x & 15; return (k << 4) + ((k & 1) ? 15 - c : c); }

__global__ void __launch_bounds__(512, 2) fwd(Args a) {
    extern __shared__ __attribute__((aligned(16))) unsigned char smem[];
    LAS char* lds = (LAS char*)smem;
    LAS unsigned* xbw = (LAS unsigned*)(lds + cfg::LDS_BYTES - 16);
    if (threadIdx.x < 4) xbw[threadIdx.x] = 0u;
    __syncthreads();
    XcdBarrier bar = xcd_barrier_post((unsigned*)(a.ws + wsm::CTL), (volatile LAS unsigned*)xbw);
    const int G = gridDim.x, wg = blockIdx.x;
    int pc = 0; bool on;
#define PH_BEGIN() (on = (pc >= a.ph_lo && pc < a.ph_hi))
#define PH_END() do { if (on && pc + 1 < a.ph_hi) xcd_barrier(bar); ++pc; } while (0)
    using namespace cfg;
    bf16_t* const xb = ph::wsb(a, wsm::XB); float* const ssq = ph::wsf(a, wsm::SSQ); bf16_t* const actz = ph::wsb(a, wsm::ACTZ); bf16_t* const mix = ph::wsb(a, wsm::MIX);

    if (PH_BEGIN()) ph::prologue(a, lds);
    PH_END();

    for (int L = 0; L < 2; ++L) {
        for (int hf = 0; hf < 2; ++hf) {
            if (hf == 1) {
                if (PH_BEGIN()) { pg8::Gemm g{xb, ph::wsb(a, wsm::WIN + L * wsm::WIN_1), M, ZLD, D}; pg8::StaticOrder so; so.init(M, ZLD, G, wg);
                    pg8::EpiZ E{actz, ZLD, ssq}; pg8::gemm_phase<pg8::EpiZ, pg8::StaticOrder, false>((PG8_LAS unsigned char*)smem, g, so, E, nullptr); }
                PH_END();
                if (L == 0) {
                    if (PH_BEGIN()) {
                        for (int u = wg; u < 768; u += G) ph::compress_unit(a, u, lds);
                        for (int u = wg; u < 256; u += G) ph::gmlp_unit(a, u, lds);
                        for (int u = wg; u < 1024; u += G) ph::rope_even_unit(a, u);
                    }
                    PH_END();
                    if (PH_BEGIN()) {
                        for (int idx = wg; idx < 1536; idx += G) { const int b = idx & 15, rest = bal16(idx >> 4); ph::nsa_unit(a, b, rest % 3, rest / 3, lds); }
                    }
                    PH_END();
                } else {
                    if (PH_BEGIN()) { for (int u = wg; u < 1024; u += G) ph::rope_odd_unit(a, u); }
                    PH_END();
                    if (PH_BEGIN()) {
                        for (int idx = wg; idx < 2048; idx += G) ph::dsa_select_unit(a, idx & 15, bal16(idx >> 4), lds);
                        for (int u = wg; u < 128; u += G) ph::kmean_unit(a, u);
                    }
                    PH_END();
                    if (PH_BEGIN()) {
                        for (int idx = wg; idx < 1024; idx += G) ph::dsa_attn_unit(a, idx & 15, bal16(idx >> 4), lds);
                        for (int idx = wg; idx < 1024; idx += G) { const int r = bal16(idx >> 4); ph::moba_unit(a, idx & 15, r & 7, r >> 3, lds); }
                    }
                    PH_END();
                }
                if (PH_BEGIN()) { pg8::Gemm g{mix, ph::wsb(a, wsm::WOUT + L * wsm::WOUT_1), M, D, D}; pg8::StaticOrder so; so.init(M, D, G, wg);
                    pg8::EpiResid E{a.out, a.out, xb, ssq, 1.0f}; pg8::gemm_phase<pg8::EpiResid, pg8::StaticOrder, false>((PG8_LAS unsigned char*)smem, g, so, E, nullptr); }
                PH_END();
            }
            const int f = 2 * L + hf;
            if (PH_BEGIN()) { pg8::Gemm g{xb, ph::wsb(a, wsm::WGU + f * wsm::WGU_1), M, NGU, D}; pg8::StaticOrder so; so.init(M, NGU, G, wg);
                pg8::EpiSwiGLU E{actz, ssq}; pg8::gemm_phase<pg8::EpiSwiGLU, pg8::StaticOrder, false>((PG8_LAS unsigned char*)smem, g, so, E, nullptr); }
            PH_END();
            if (PH_BEGIN()) { pg8::Gemm g{actz, ph::wsb(a, wsm::WD + f * wsm::WD_1), M, D, FF}; pg8::StaticOrder so; so.init(M, D, G, wg);
                pg8::EpiResid E{f == 0 ? a.in[0] : (const float*)a.out, a.out, xb, ssq, 0.5f}; pg8::gemm_phase<pg8::EpiResid, pg8::StaticOrder, false>((PG8_LAS unsigned char*)smem, g, so, E, nullptr); }
            PH_END();
        }
    }
    if (PH_BEGIN()) ph::final_norm(a);
    PH_END();
#undef PH_BEGIN
#undef PH_END
}

extern "C" void kernel_launch(void* const* d_in, const int* in_sizes, int n_in, void* d_out, int out_size, void* d_ws, size_t ws_size, hipStream_t stream) {
    static int grid = 0;
    if (grid == 0) {
        if (n_in != 25 || out_size != cfg::M * cfg::D || ws_size < wsm::END) { fprintf(stderr, "kernel_launch: unexpected shapes (n_in %d, out %d, ws %zu < %zu)\n", n_in, out_size, ws_size, (size_t)wsm::END); grid = -1; return; }
        int dev = 0, cus = 0;
        if (hipGetDevice(&dev) != hipSuccess || hipDeviceGetAttribute(&cus, hipDeviceAttributeMultiprocessorCount, dev) != hipSuccess) { grid = -1; return; }
        if (hipFuncSetAttribute((const void*)fwd, hipFuncAttributeMaxDynamicSharedMemorySize, cfg::LDS_BYTES) != hipSuccess) { fprintf(stderr, "kernel_launch: hipFuncSetAttribute failed\n"); grid = -1; return; }
        int per_cu = 0; (void)hipOccupancyMaxActiveBlocksPerMultiprocessor(&per_cu, (const void*)fwd, 512, cfg::LDS_BYTES); (void)hipGetLastError();
        grid = cus;
    }
    if (grid < 0) return;
    (void)hipMemsetAsync((char*)d_ws + wsm::CTL, 0, wsm::CTL_BYTES, stream);
    Args a{};
    for (int i = 0; i < 25; ++i) a.in[i] = (const float*)d_in[i];
    a.out = (float*)d_out; a.ws = (unsigned char*)d_ws;
#if MK_ONE_LAUNCH
    a.ph_lo = 0; a.ph_hi = N_PHASES;
    hipLaunchKernelGGL(fwd, dim3(grid), dim3(512), cfg::LDS_BYTES, stream, a);
#else
    for (int p = 0; p < N_PHASES; ++p) { a.ph_lo = p; a.ph_hi = p + 1; hipLaunchKernelGGL(fwd, dim3(grid), dim3(512), cfg::LDS_BYTES, stream, a); }
#endif
}
```

```cpp
#include <hip/hip_runtime.h>
#include <stdint.h>
#include <stdio.h>

#define LAS __attribute__((address_space(3)))
typedef unsigned short bf16_t;
typedef short bf16x8 __attribute__((ext_vector_type(8)));
typedef short s16x4 __attribute__((ext_vector_type(4)));
typedef float f32x4 __attribute__((ext_vector_type(4)));
typedef float f32x16 __attribute__((ext_vector_type(16)));
typedef unsigned u32x4 __attribute__((ext_vector_type(4)));
typedef unsigned u32x2 __attribute__((ext_vector_type(2)));

namespace cfg {
constexpr int B = 16, S = 2048, D = 1024, M = B * S, FF = 2816, NGU = 2 * FF, ZLD = 2560, NTHR = 512;
constexpr int EV_NSRC = 2468, OD_NSRC = 2340;
constexpr int E_A = 0, E_Q = 512, E_KC = 1280, E_VC = 1472, E_KS = 1664, E_VS = 1856, E_KW = 2048, E_VW = 2240, E_GL = 2432;
constexpr int O_QC = 0, O_KC = 512, O_VC = 576, O_QI = 640, O_KI = 768, O_QD = 832, O_KD = 1344, O_VD = 1856, O_WI = 2368;
constexpr float EPS = 1e-6f;
constexpr float C2 = 0.125f * 1.4426950408889634f;
constexpr int LDS_BYTES = 144 * 1024;
}

namespace wsm {
constexpr size_t al(size_t x) { return (x + 255) & ~(size_t)255; }
constexpr size_t CTL = 0, CTL_BYTES = 16384;
constexpr size_t WGU = CTL + CTL_BYTES;                                  constexpr size_t WGU_1 = (size_t)cfg::NGU * cfg::D * 2;
constexpr size_t WD = WGU + 4 * WGU_1;                                   constexpr size_t WD_1 = (size_t)cfg::D * cfg::FF * 2;
constexpr size_t WIN = WD + 4 * WD_1;                                    constexpr size_t WIN_1 = (size_t)cfg::ZLD * cfg::D * 2;
constexpr size_t WOUT = WIN + 2 * WIN_1;                                 constexpr size_t WOUT_1 = (size_t)cfg::D * cfg::D * 2;
constexpr size_t CW1T = WOUT + 2 * WOUT_1;                               constexpr size_t CW1T_1 = (size_t)256 * 2048 * 2;
constexpr size_t CW2T = CW1T + 2 * CW1T_1;                               constexpr size_t CW2T_1 = (size_t)64 * 256 * 2;
constexpr size_t SGUW = CW2T + 2 * CW2T_1;
constexpr size_t C1P = SGUW + (size_t)4 * 128 * 128 * 2;
constexpr size_t ROPE16 = C1P + (size_t)2 * 32 * 256 * 4;
constexpr size_t ROPE8 = ROPE16 + (size_t)cfg::M * 16 * 4;
constexpr size_t SSQ = ROPE8 + (size_t)cfg::M * 8 * 4;
constexpr size_t XB = SSQ + (size_t)cfg::M * 16 * 4;
constexpr size_t ACTZ = XB + (size_t)cfg::M * cfg::D * 2;
constexpr size_t QROT = ACTZ + (size_t)cfg::M * cfg::FF * 2;
constexpr size_t MIX = QROT + (size_t)cfg::M * 768 * 2;
constexpr size_t KCMP = MIX + (size_t)cfg::M * 1024 * 2;
constexpr size_t VCMP = KCMP + (size_t)cfg::B * 3 * 128 * 64 * 2;
constexpr size_t DMASK = VCMP + (size_t)cfg::B * 3 * 128 * 64 * 2;
constexpr size_t KMEAN = DMASK + (size_t)cfg::M * 64 * 4;
constexpr size_t END = KMEAN + (size_t)cfg::B * 8 * 8 * 64 * 4;
static_assert(WGU % 256 == 0 && WD % 256 == 0 && ACTZ % 256 == 0 && QROT % 256 == 0 && KCMP % 256 == 0 && DMASK % 256 == 0, "alignment");
}

struct Args {
    const float* in[25];
    float* out;
    unsigned char* ws;
    int ph_lo, ph_hi;
};

__device__ __forceinline__ float bf2f(bf16_t b) { return __uint_as_float(((unsigned)b) << 16); }
__device__ __forceinline__ float bflo(unsigned w) { return __uint_as_float(w << 16); }
__device__ __forceinline__ float bfhi(unsigned w) { return __uint_as_float(w & 0xffff0000u); }
__device__ __forceinline__ bf16_t f2bf(float f) { unsigned u = __float_as_uint(f); u += 0x7FFFu + ((u >> 16) & 1u); return (bf16_t)(u >> 16); }
typedef __bf16 bf16v2_t __attribute__((ext_vector_type(2)));
typedef float f32v2_t __attribute__((ext_vector_type(2)));
__device__ __forceinline__ unsigned pk2(float lo, float hi) { const f32v2_t v = {lo, hi}; const bf16v2_t b = __builtin_convertvector(v, bf16v2_t); return __builtin_bit_cast(unsigned, b); }
__device__ __forceinline__ float fast_exp(float x) { return __builtin_amdgcn_exp2f(x * 1.4426950408889634f); }
__device__ __forceinline__ float sigmoidf_(float x) { return __builtin_amdgcn_rcpf(1.0f + fast_exp(-x)); }
__device__ __forceinline__ float gelu_tanh(float x) { const float y = 1.5957691216057308f * (x + 0.044715f * x * x * x); return x * sigmoidf_(y); }
__device__ __forceinline__ int crow(int r, int hi) { return (r & 3) + 8 * (r >> 2) + 4 * hi; }
__device__ __forceinline__ float swap32_max(float m) { auto rr = __builtin_amdgcn_permlane32_swap(__float_as_uint(m), __float_as_uint(m), false, false); return __builtin_fmaxf(__uint_as_float(rr[0]), __uint_as_float(rr[1])); }
__device__ __forceinline__ float swap32_sum(float m) { auto rr = __builtin_amdgcn_permlane32_swap(__float_as_uint(m), __float_as_uint(m), false, false); return __uint_as_float(rr[0]) + __uint_as_float(rr[1]); }
#define MFMA32(a, b, c) __builtin_amdgcn_mfma_f32_32x32x16_bf16(a, b, c, 0, 0, 0)
#define MFMA16(a, b, c) __builtin_amdgcn_mfma_f32_16x16x32_bf16(a, b, c, 0, 0, 0)
__device__ __forceinline__ s16x4 tr16(const char* p) { typedef short v4i16_t __attribute__((ext_vector_type(4))); return __builtin_bit_cast(s16x4, __builtin_amdgcn_ds_read_tr16_b64_v4i16((LAS v4i16_t*)p)); }
__device__ __forceinline__ float rstd_from_ssq(const float* ssq, int row) {
    const f32x4* p = (const f32x4*)(ssq + (size_t)row * 16); const f32x4 a = p[0], b = p[1], c = p[2], d = p[3];
    const float s = ((a[0] + a[1]) + (a[2] + a[3])) + ((b[0] + b[1]) + (b[2] + b[3])) + ((c[0] + c[1]) + (c[2] + c[3])) + ((d[0] + d[1]) + (d[2] + d[3]));
    return __builtin_amdgcn_rsqf(s * (1.0f / 1024.0f) + cfg::EPS);
}
namespace pg8 {
#define PG8_LAS __attribute__((address_space(3)))
typedef unsigned short bf16_t;
typedef short bf16x8 __attribute__((ext_vector_type(8)));
typedef float f32x4 __attribute__((ext_vector_type(4)));
typedef unsigned u32x4 __attribute__((ext_vector_type(4)));
constexpr int BM = 256, BK = 64, HALF = 128, HTB = HALF * BK * 2  , STAGE_BYTES = 8 * HTB, NXCD = 8, WGM = 8;

__host__ __device__ __forceinline__ int lds_byte(int r, int c) { const int st = (r >> 4) * 2 + (c >> 5), rr = r & 15, cc = c & 31, ob = rr * 64 + cc * 2; return st * 1024 + (ob ^ (((ob >> 9) & 1) << 5)); }
__host__ __device__ __forceinline__ void stage_rc(int b, int& R, int& C) { const int st = b / 1024, sb = b % 1024, swz = sb ^ (((sb >> 9) & 1) << 5); R = (st >> 1) * 16 + swz / 64; C = (st & 1) * 32 + (swz % 64) / 2; }
__host__ __device__ __forceinline__ int perm32(int rho) { const int n = rho >> 4, i = rho & 15; return 8 * (i >> 2) + 4 * n + (i & 3); }

struct Unit { int pm, pn; };
struct Gemm { const bf16_t* A; const bf16_t* Bt; int M, N, K; };

struct StaticOrder {
    int nM, nN, nwg, G, c;
    __host__ __device__ void init(int M, int N, int G_, int c_) { nM = M / BM; nN = N / BM; nwg = nM * nN; G = G_; c = c_; }
    __host__ __device__ bool next(int i, Unit& u) const {
        const long L = (long)i * G + c; if (L >= nwg) return false;
        int wgid = (int)L; { const int q = nwg / NXCD, r = nwg % NXCD, xcd = wgid % NXCD, off = wgid / NXCD; wgid = (xcd < r ? xcd * (q + 1) : r * (q + 1) + (xcd - r) * q) + off; }
        const int nig = WGM * nN, gid = wgid / nig, fm = gid * WGM, gsz = (nM - fm) < WGM ? (nM - fm) : WGM;
        u.pm = fm + ((wgid % nig) % gsz); u.pn = (wgid % nig) / gsz; return true;
    }
    __device__ __forceinline__ void a_ready(const Unit&) const {}
    __device__ __forceinline__ void done(const Unit&) const {}
};
__device__ __forceinline__ unsigned cvt_pk_bf16(float lo, float hi) { unsigned r; asm volatile("v_cvt_pk_bf16_f32 %0, %1, %2" : "=v"(r) : "v"(lo), "v"(hi)); return r; }
typedef float f32x2 __attribute__((ext_vector_type(2)));
struct EpiSwiGLU {
    static constexpr bool PERM = true, AFTER_DRAIN = false;
    bf16_t* act; const float* ssq;
    __device__ __forceinline__ void operator()(const f32x4 (&acc)[2][2][4][2], const Unit& u, int wr, int wc, int fr, int fq) const {
        const int row0 = u.pm * BM + wr * 64 + fr, col0 = u.pn * 128 + wc * 32 + 8 * fq;
#pragma unroll
        for (int ai = 0; ai < 2; ++ai)
#pragma unroll
            for (int m = 0; m < 4; ++m) {
                const int row = row0 + ai * HALF + m * 16; const float rs = rstd_from_ssq(ssq, row);
                float o[8];
#pragma unroll
                for (int n = 0; n < 2; ++n)
#pragma unroll
                    for (int j = 0; j < 4; ++j) { const float g = acc[ai][0][m][n][j] * rs, up = acc[ai][1][m][n][j] * rs; o[n * 4 + j] = g * sigmoidf_(g) * up; }
                u32x4 w; w.x = pk2(o[0], o[1]); w.y = pk2(o[2], o[3]); w.z = pk2(o[4], o[5]); w.w = pk2(o[6], o[7]);
                *(u32x4*)(act + (size_t)row * cfg::FF + col0) = w;
            }
    }
};
struct EpiZ {
    static constexpr bool PERM = true, AFTER_DRAIN = false;
    bf16_t* z; int ldc; const float* ssq;
    __device__ __forceinline__ void operator()(const f32x4 (&acc)[2][2][4][2], const Unit& u, int wr, int wc, int fr, int fq) const {
        const int row0 = u.pm * BM + wr * 64 + fr, col0 = u.pn * BM + wc * 32 + 8 * fq;
#pragma unroll
        for (int ai = 0; ai < 2; ++ai)
#pragma unroll
            for (int m = 0; m < 4; ++m) {
                const int row = row0 + ai * HALF + m * 16; const float rs = rstd_from_ssq(ssq, row);
#pragma unroll
                for (int bj = 0; bj < 2; ++bj) { const f32x4 v0 = acc[ai][bj][m][0] * rs, v1 = acc[ai][bj][m][1] * rs;
                    u32x4 w; w.x = pk2(v0[0], v0[1]); w.y = pk2(v0[2], v0[3]); w.z = pk2(v1[0], v1[1]); w.w = pk2(v1[2], v1[3]);
                    *(u32x4*)(z + (size_t)row * ldc + col0 + bj * HALF) = w; }
            }
    }
};
struct EpiResid {
    static constexpr bool PERM = true, AFTER_DRAIN = false;
    bf16_t* xb; float* ssq; float coef;
    __device__ __forceinline__ void operator()(const f32x4 (&acc)[2][2][4][2], const Unit& u, int wr, int wc, int fr, int fq) const {
        const int row0 = u.pm * BM + wr * 64 + fr, col0 = u.pn * BM + wc * 32 + 8 * fq;
#pragma unroll
        for (int ai = 0; ai < 2; ++ai)
#pragma unroll
            for (int m = 0; m < 4; ++m) {
                const int row = row0 + ai * HALF + m * 16; bf16_t* xp = xb + (size_t)row * cfg::D + col0; float s = 0.f;
                const u32x4 x0 = *(const u32x4*)xp, x1 = *(const u32x4*)(xp + HALF);
#pragma unroll
                for (int bj = 0; bj < 2; ++bj) { const u32x4 xi = bj ? x1 : x0; const f32x4 a0 = acc[ai][bj][m][0], a1 = acc[ai][bj][m][1]; float o[8];
                    o[0] = bflo(xi[0]) + coef * a0[0]; o[1] = bfhi(xi[0]) + coef * a0[1]; o[2] = bflo(xi[1]) + coef * a0[2]; o[3] = bfhi(xi[1]) + coef * a0[3];
                    o[4] = bflo(xi[2]) + coef * a1[0]; o[5] = bfhi(xi[2]) + coef * a1[1]; o[6] = bflo(xi[3]) + coef * a1[2]; o[7] = bfhi(xi[3]) + coef * a1[3];
#pragma unroll
                    for (int j = 0; j < 8; ++j) s += o[j] * o[j];
                    u32x4 w; w.x = pk2(o[0], o[1]); w.y = pk2(o[2], o[3]); w.z = pk2(o[4], o[5]); w.w = pk2(o[6], o[7]);
                    *(u32x4*)(xp + bj * HALF) = w; }
                s += __shfl_xor(s, 16); s += __shfl_xor(s, 32);
                if (fq == 0) ssq[(size_t)row * 16 + u.pn * 4 + wc] = s;
            }
    }
};
template <class Epi, class Sched, bool STAMP = false>
__device__ __forceinline__ void gemm_phase(PG8_LAS unsigned char* lds, const Gemm g, const Sched& S, const Epi& E, unsigned long long* stamps) {
    int tid_ = threadIdx.x; asm volatile("" : "+v"(tid_)); const int tid = tid_, wid = __builtin_amdgcn_readfirstlane(tid >> 6), lane = tid & 63, wr = wid >> 2, wc = wid & 3, fr = lane & 15, fq = lane >> 4;
    const int K = g.K, nt = K / BK;
    int ts_lo = 0, ts_hi = 0, nts = 0; const unsigned long long rt_entry = STAMP ? (unsigned long long)wall_clock64() : 0ull;
#define PG8_STAMP() do { if (STAMP && wid == 0 && nts < 64) { const unsigned long long _c = (unsigned long long)clock64(); \
        ts_lo = (lane == nts) ? (int)(unsigned)_c : ts_lo; ts_hi = (lane == nts) ? (int)(unsigned)(_c >> 32) : ts_hi; ++nts; } } while (0)
    PG8_STAMP();
    unsigned voffA[2], voffB[2];
#pragma unroll
    for (int i = 0; i < 2; ++i) { int R, C; stage_rc(tid * 16 + i * 8192, R, C); const int Rb = Epi::PERM ? ((R & ~31) + perm32(R & 31)) : R;
        voffA[i] = (unsigned)(R * K + C) * 2u; voffB[i] = (unsigned)(Rb * K + C) * 2u; }
    const size_t kstep = (size_t)(BK * 2);
    const size_t hstep = (size_t)HALF * K * 2;
    const size_t tstep = 2 * hstep;
    const unsigned ldsw = (unsigned)wid * 1024u;
    const int aoff = lds_byte(wr * 64 + fr, fq * 8), boff = lds_byte(wc * 32 + fr, fq * 8);
#define PG8_SA(b, h) (((b) * 2 + (h)) * HTB)
#define PG8_SB(b, h) ((4 + (b) * 2 + (h)) * HTB)
#define PG8_STAGE(bufoff, gbase, voff) do { _Pragma("unroll") for (int _i = 0; _i < 2; ++_i) \
        __builtin_amdgcn_global_load_lds((const unsigned*)((const char*)(gbase) + (voff)[_i]), (PG8_LAS unsigned*)(lds + (bufoff) + ldsw + _i * 8192), 16, 0, 0); } while (0)
#define PG8_LDA(dst, b, h) do { _Pragma("unroll") for (int m = 0; m < 4; ++m) _Pragma("unroll") for (int k = 0; k < 2; ++k) dst[m][k] = *(const PG8_LAS bf16x8*)(lds + PG8_SA(b, h) + aoff + m * 2048 + k * 1024); } while (0)
#define PG8_LDB(dst, b, h) do { _Pragma("unroll") for (int n = 0; n < 2; ++n) _Pragma("unroll") for (int k = 0; k < 2; ++k) dst[n][k] = *(const PG8_LAS bf16x8*)(lds + PG8_SB(b, h) + boff + n * 2048 + k * 1024); } while (0)
#define PG8_MMA(ai, bj, At, Bt) do { __builtin_amdgcn_s_setprio(1); _Pragma("unroll") for (int m = 0; m < 4; ++m) _Pragma("unroll") for (int n = 0; n < 2; ++n) _Pragma("unroll") for (int k = 0; k < 2; ++k) \
        acc[ai][bj][m][n] = __builtin_amdgcn_mfma_f32_16x16x32_bf16(Bt[n][k], At[m][k], acc[ai][bj][m][n], 0, 0, 0); __builtin_amdgcn_s_setprio(0); } while (0)
#define PG8_WAIT_V(n) asm volatile("s_waitcnt vmcnt(" #n ")" ::: "memory")
#define PG8_WAIT_L(n) asm volatile("s_waitcnt lgkmcnt(" #n ")" ::: "memory")
#define PG8_BAR __builtin_amdgcn_s_barrier()
#define PG8_SCHED __builtin_amdgcn_sched_barrier(0)
    Unit cur, nxt; int ui = 0;
    if (!S.next(0, cur)) return;
    f32x4 acc[2][2][4][2];
#pragma unroll
    for (int a = 0; a < 2; ++a)
#pragma unroll
        for (int b = 0; b < 2; ++b)
#pragma unroll
            for (int m = 0; m < 4; ++m)
#pragma unroll
                for (int n = 0; n < 2; ++n) acc[a][b][m][n] = (f32x4){0.f, 0.f, 0.f, 0.f};
    bf16x8 At[4][2], B0[2][2], B1[2][2];
    const char* cA = (const char*)g.A + (size_t)cur.pm * tstep; const char* cB = (const char*)g.Bt + (size_t)cur.pn * tstep;
    S.a_ready(cur);
    PG8_STAGE(PG8_SB(0, 0), cB, voffB); PG8_STAGE(PG8_SA(0, 0), cA, voffA); PG8_STAGE(PG8_SB(0, 1), cB + hstep, voffB); PG8_STAGE(PG8_SA(0, 1), cA + hstep, voffA);
    if (wr == 1) PG8_BAR;
    PG8_WAIT_V(4); PG8_BAR;
    PG8_STAGE(PG8_SB(1, 0), cB + kstep, voffB); PG8_STAGE(PG8_SA(1, 0), cA + kstep, voffA); PG8_STAGE(PG8_SB(1, 1), cB + hstep + kstep, voffB);
    PG8_WAIT_V(6); PG8_BAR;
    PG8_STAMP();
    for (;;) {
        const bool has_next = S.next(ui + 1, nxt);
        const char* nA = has_next ? (const char*)g.A + (size_t)nxt.pm * tstep : cA; const char* nB = has_next ? (const char*)g.Bt + (size_t)nxt.pn * tstep : cB;
        for (int t = 0; t < nt; t += 2) {
            const bool last = (t == nt - 2);
            const char* a1 = cA + (size_t)(t + 1) * kstep;
            const char* a2 = last ? nA : cA + (size_t)(t + 2) * kstep; const char* b2 = last ? nB : cB + (size_t)(t + 2) * kstep;
            const char* a3 = a2 + kstep; const char* b3 = b2 + kstep;
            if (last && has_next) S.a_ready(nxt);
            PG8_LDB(B0, 0, 0); PG8_SCHED; PG8_LDA(At, 0, 0); PG8_STAGE(PG8_SA(1, 1), a1 + hstep, voffA);
            PG8_WAIT_L(8); PG8_BAR; PG8_WAIT_L(0); PG8_MMA(0, 0, At, B0); PG8_BAR; PG8_SCHED;
            PG8_LDB(B1, 0, 1); PG8_STAGE(PG8_SB(0, 0), b2, voffB);
            PG8_BAR; PG8_WAIT_L(0); PG8_MMA(0, 1, At, B1); PG8_BAR;
            PG8_LDA(At, 0, 1); PG8_STAGE(PG8_SA(0, 0), a2, voffA);
            PG8_BAR; PG8_WAIT_L(0); PG8_MMA(1, 0, At, B0); PG8_BAR; PG8_SCHED;
            PG8_STAGE(PG8_SB(0, 1), b2 + hstep, voffB);
            PG8_WAIT_V(6); PG8_BAR; PG8_MMA(1, 1, At, B1); PG8_BAR;
            PG8_LDB(B0, 1, 0); PG8_SCHED; PG8_LDA(At, 1, 0); PG8_STAGE(PG8_SA(0, 1), a2 + hstep, voffA);
            PG8_WAIT_L(8); PG8_BAR; PG8_WAIT_L(0); PG8_MMA(0, 0, At, B0); PG8_BAR; PG8_SCHED;
            PG8_LDB(B1, 1, 1); PG8_STAGE(PG8_SB(1, 0), b3, voffB);
            PG8_BAR; PG8_WAIT_L(0); PG8_MMA(0, 1, At, B1); PG8_BAR;
            PG8_LDA(At, 1, 1); PG8_STAGE(PG8_SA(1, 0), a3, voffA);
            PG8_BAR; PG8_WAIT_L(0); PG8_MMA(1, 0, At, B0); PG8_BAR; PG8_SCHED;
            PG8_STAGE(PG8_SB(1, 1), b3 + hstep, voffB);
            PG8_WAIT_V(6); PG8_BAR; PG8_MMA(1, 1, At, B1); PG8_BAR;
        }
        PG8_STAMP();
        if constexpr (!Epi::AFTER_DRAIN) { E(acc, cur, wr, wc, fr, fq); S.done(cur); }
        PG8_STAMP();
        if (!has_next) break;
#pragma unroll
        for (int a = 0; a < 2; ++a)
#pragma unroll
            for (int b = 0; b < 2; ++b)
#pragma unroll
                for (int m = 0; m < 4; ++m)
#pragma unroll
                    for (int n = 0; n < 2; ++n) acc[a][b][m][n] = (f32x4){0.f, 0.f, 0.f, 0.f};
        cur = nxt; cA = nA; cB = nB; ++ui;
    }
    PG8_WAIT_V(0);
    if (wr == 0) PG8_BAR;
    PG8_BAR;
    if constexpr (Epi::AFTER_DRAIN) { E.fused(acc, cur, wr, wc, fr, fq, lds, wid, lane); S.done(cur); }
    PG8_STAMP();
    if (STAMP && wid == 0) { stamps[lane] = lane < nts ? (((unsigned long long)(unsigned)ts_hi << 32) | (unsigned)ts_lo) : 0ull;
        if (lane == 62) stamps[62] = rt_entry; if (lane == 63) stamps[63] = (unsigned long long)wall_clock64(); }
#undef PG8_STAMP
#undef PG8_SA
#undef PG8_SB
#undef PG8_STAGE
#undef PG8_LDA
#undef PG8_LDB
#undef PG8_MMA
#undef PG8_WAIT_V
#undef PG8_WAIT_L
#undef PG8_BAR
#undef PG8_SCHED
}
}
namespace ph {
using namespace cfg;
typedef LAS char* ldsp;
#ifdef PROBE_SUB
__device__ __forceinline__ unsigned long long rt_now_() { unsigned long long t; asm volatile("s_memrealtime %0\n\ts_waitcnt lgkmcnt(0)" : "=s"(t) :: "memory"); return t; }
#define SUBT_BEGIN(id) unsigned long long subt0_##id = (PROBE_SUB == (id)) ? ph::rt_now_() : 0ull
#define SUBT_END(id, lds_) do { if (PROBE_SUB == (id) && threadIdx.x == 0) *(LAS unsigned*)((lds_) + cfg::LDS_BYTES - 8) += (unsigned)(ph::rt_now_() - subt0_##id); } while (0)
#else
#define SUBT_BEGIN(id) do {} while (0)
#define SUBT_END(id, lds_) do {} while (0)
#endif
__device__ __forceinline__ int otid() { int t = threadIdx.x; asm volatile("" : "+v"(t)); return t; }

__device__ __forceinline__ bf16_t* wsb(const Args& a, size_t off) { return (bf16_t*)(a.ws + off); }
__device__ __forceinline__ float* wsf(const Args& a, size_t off) { return (float*)(a.ws + off); }

struct CvtJob { const float* src0; const float* src1; const float* gain; bf16_t* dst; int K, Nsrc, Ndst, mode; };
constexpr int T_GU = 16 * 22, T_DN = 44 * 4, T_WIN = 16 * 10, T_WOUT = 16 * 4, T_CW1 = 32 * 1, T_CW2 = 4 * 1;
constexpr int CVT_TILES = 4 * T_GU + 4 * T_DN + 2 * T_WIN + 2 * T_WOUT + 2 * T_CW1 + 2 * T_CW2;
__device__ __forceinline__ int odd_colmap(int n) { if (n < 800) return n; if (n < 832) return -1; if (n < 2368) return n - 28; if (n < 2372) return 800 + (n - 2368); return -1; }
__device__ __forceinline__ int cvt_job(const Args& a, int tile, CvtJob& J) {
    if (tile < 4 * T_GU) { const int f = tile / T_GU, L = f >> 1, w = f & 1; const size_t o = (size_t)L * D * FF;
        J = CvtJob{a.in[w ? 8 : 3] + o, a.in[w ? 9 : 4] + o, a.in[w ? 7 : 2] + L * D, wsb(a, wsm::WGU + f * wsm::WGU_1), D, FF, NGU, 1}; return tile - f * T_GU; }
    tile -= 4 * T_GU;
    if (tile < 4 * T_DN) { const int f = tile / T_DN, L = f >> 1, w = f & 1; const size_t o = (size_t)L * D * FF;
        J = CvtJob{a.in[w ? 10 : 5] + o, nullptr, nullptr, wsb(a, wsm::WD + f * wsm::WD_1), FF, D, D, 0}; return tile - f * T_DN; }
    tile -= 4 * T_DN;
    if (tile < T_WIN) { J = CvtJob{a.in[11], nullptr, a.in[6], wsb(a, wsm::WIN), D, EV_NSRC, ZLD, 0}; return tile; }
    tile -= T_WIN;
    if (tile < T_WIN) { J = CvtJob{a.in[22], nullptr, a.in[6] + D, wsb(a, wsm::WIN + wsm::WIN_1), D, OD_NSRC, ZLD, 2}; return tile; }
    tile -= T_WIN;
    if (tile < T_WOUT) { J = CvtJob{a.in[21], nullptr, nullptr, wsb(a, wsm::WOUT), D, D, D, 0}; return tile; }
    tile -= T_WOUT;
    if (tile < T_WOUT) { J = CvtJob{a.in[23], nullptr, nullptr, wsb(a, wsm::WOUT + wsm::WOUT_1), D, D, D, 0}; return tile; }
    tile -= T_WOUT;
    if (tile < 2 * T_CW1) { const int kv = tile / T_CW1; J = CvtJob{a.in[kv ? 19 : 16], nullptr, nullptr, wsb(a, wsm::CW1T + kv * wsm::CW1T_1), 2048, 256, 256, 0}; return tile - kv * T_CW1; }
    tile -= 2 * T_CW1;
    { const int kv = tile / T_CW2; J = CvtJob{a.in[kv ? 20 : 17], nullptr, nullptr, wsb(a, wsm::CW2T + kv * wsm::CW2T_1), 256, 64, 64, 0}; return tile - kv * T_CW2; }
}
__device__ __forceinline__ void cvt_tile(const CvtJob& J, int tile, ldsp lds) {
    const int tid = otid(), nb = J.Ndst >= 256 ? 4 : 1, ntn = J.Ndst / (64 * nb), tk = tile / ntn, tn = tile - tk * ntn, k0 = tk * 64, n0 = tn * 64 * nb;
    LAS bf16_t* T = (LAS bf16_t*)lds;
    { const int nn = tid & 63, kq = tid >> 6; float v[4][8];
#pragma unroll
      for (int q = 0; q < 4; ++q) { const int n = n0 + 64 * q + nn; const float* src = J.src0; int col;
          if (J.mode == 0) col = n < J.Nsrc ? n : -1;
          else if (J.mode == 1) { col = (n >> 8) * 128 + (n & 127); if ((n >> 7) & 1) src = J.src1; }
          else col = odd_colmap(n);
          if (q >= nb) col = -1;
#pragma unroll
          for (int i = 0; i < 8; ++i) v[q][i] = col >= 0 ? src[(size_t)(k0 + kq + 8 * i) * J.Nsrc + col] : 0.f; }
      float g[8];
#pragma unroll
      for (int i = 0; i < 8; ++i) g[i] = J.gain ? J.gain[k0 + kq + 8 * i] : 1.0f;
#pragma unroll
      for (int q = 0; q < 4; ++q)
#pragma unroll
          for (int i = 0; i < 8; ++i) T[(64 * q + nn) * 72 + kq + 8 * i] = f2bf(v[q][i] * g[i]); }
    __syncthreads();
#pragma unroll
    for (int q = 0; q < 4; ++q) if (q < nb) { const int nn = 64 * q + (tid >> 3), kc = tid & 7; const u32x4 w = *(const LAS u32x4*)(T + nn * 72 + kc * 8); *(u32x4*)(J.dst + (size_t)(n0 + nn) * J.K + k0 + kc * 8) = w; }
    __syncthreads();
}
__device__ __forceinline__ void sincos_pos(float ang, float& s, float& c) {
    const double k = __builtin_rint((double)ang * 0.15915494309189535); const float r = (float)__builtin_fma(-k, 6.283185307179586, (double)ang);
    s = __sinf(r); c = __cosf(r);
}
__device__ __forceinline__ void prologue(const Args& a, ldsp lds) {
    const int tid = otid(), wid = tid >> 6, lane = tid & 63, G = gridDim.x, wg = blockIdx.x;
    for (int t = wg; t < CVT_TILES; t += G) { CvtJob J; const int lt = cvt_job(a, t, J); cvt_tile(J, lt, lds); }
    { const float* x = a.in[0]; bf16_t* xb = wsb(a, wsm::XB); float* ssq = wsf(a, wsm::SSQ);
      for (int row = wg * 8 + wid; row < M; row += G * 16) {
          const int row2 = row + G * 8; const bool has2 = row2 < M; const int r2 = has2 ? row2 : row;
          f32x4 va[4], vb[4];
#pragma unroll
          for (int i = 0; i < 4; ++i) { va[i] = *(const f32x4*)(x + (size_t)row * D + i * 256 + lane * 4); vb[i] = *(const f32x4*)(x + (size_t)r2 * D + i * 256 + lane * 4); }
          float s0 = 0.f, s1 = 0.f;
#pragma unroll
          for (int i = 0; i < 4; ++i) { const int c = i * 256 + lane * 4; u32x2 w; w.x = pk2(va[i][0], va[i][1]); w.y = pk2(va[i][2], va[i][3]); *(u32x2*)(xb + (size_t)row * D + c) = w; s0 += (va[i][0] * va[i][0] + va[i][1] * va[i][1]) + (va[i][2] * va[i][2] + va[i][3] * va[i][3]);
              if (has2) { u32x2 w2; w2.x = pk2(vb[i][0], vb[i][1]); w2.y = pk2(vb[i][2], vb[i][3]); *(u32x2*)(xb + (size_t)r2 * D + c) = w2; } s1 += (vb[i][0] * vb[i][0] + vb[i][1] * vb[i][1]) + (vb[i][2] * vb[i][2] + vb[i][3] * vb[i][3]); }
#pragma unroll
          for (int o = 32; o >= 1; o >>= 1) { s0 += __shfl_xor(s0, o); s1 += __shfl_xor(s1, o); }
          if (lane < 16) { ssq[(size_t)row * 16 + lane] = lane == 0 ? s0 : 0.f; if (has2) ssq[(size_t)r2 * 16 + lane] = lane == 0 ? s1 : 0.f; }
      } }
    { const int* pos = (const int*)a.in[1]; float* r16 = wsf(a, wsm::ROPE16); float* r8 = wsf(a, wsm::ROPE8);
      const float inv16[8] = {1.0f, 0.1939227432012558f, 0.03760603070259094f, 0.007292664609849453f, 0.0014142135623842478f, 0.00027424818836152554f, 5.318296098266728e-05f, 1.0313386155758053e-05f};
      for (int i = wg * NTHR + tid; i < M; i += G * NTHR) { const float p = (float)pos[i];
#pragma unroll
          for (int j = 0; j < 8; ++j) { float s, c; sincos_pos(p * inv16[j], s, c); r16[(size_t)i * 16 + j] = c; r16[(size_t)i * 16 + 8 + j] = s;
              if ((j & 1) == 0) { r8[(size_t)i * 8 + (j >> 1)] = c; r8[(size_t)i * 8 + 4 + (j >> 1)] = s; } } } }
    { const float* w = a.in[13]; bf16_t* o = wsb(a, wsm::SGUW);
      for (int i = wg * NTHR + tid; i < 4 * 128 * 128; i += G * NTHR) { const int t = (i >> 7) & 127, s = i & 127; o[i] = f2bf(s <= t ? w[i] : 0.f); } }
    { LAS float* red = (LAS float*)lds;
      for (int u = wg; u < 64; u += G) { const int kv = u >> 5, p = u & 31, c = tid & 255, hf = tid >> 8; const float* pe = a.in[kv ? 18 : 15]; const float* w1 = a.in[kv ? 19 : 16];
          float s = 0.f; for (int i = 0; i < 32; ++i) { const int kk = p * 64 + hf * 32 + i; s += pe[kk] * w1[(size_t)kk * 256 + c]; }
          if (hf) red[c] = s; __syncthreads(); if (!hf) wsf(a, wsm::C1P)[(kv * 32 + p) * 256 + c] = s + red[c]; __syncthreads(); } }
}

__device__ __forceinline__ void final_norm(const Args& a) {
    const int tid = otid(), wid = tid >> 6, lane = tid & 63, G = gridDim.x, wg = blockIdx.x; const float* ssq = wsf(a, wsm::SSQ); const float* g = a.in[24]; const bf16_t* xb = wsb(a, wsm::XB);
    f32x4 gv[4];
#pragma unroll
    for (int i = 0; i < 4; ++i) gv[i] = *(const f32x4*)(g + lane * 16 + 4 * i);
    for (int row = wg * 8 + wid; row < M; row += G * 16) {
        const int row2 = row + G * 8; const bool has2 = row2 < M; const int r2 = has2 ? row2 : row;
        const float rs0 = rstd_from_ssq(ssq, row), rs1 = rstd_from_ssq(ssq, r2);
        const u32x4 a0 = *(const u32x4*)(xb + (size_t)row * D + lane * 16), a1 = *(const u32x4*)(xb + (size_t)row * D + lane * 16 + 8);
        const u32x4 b0 = *(const u32x4*)(xb + (size_t)r2 * D + lane * 16), b1 = *(const u32x4*)(xb + (size_t)r2 * D + lane * 16 + 8);
        float* o0 = a.out + (size_t)row * D + lane * 16; float* o1 = a.out + (size_t)r2 * D + lane * 16;
#pragma unroll
        for (int i = 0; i < 4; ++i) { const u32x4& w = i < 2 ? a0 : a1; const int k = (i & 1) * 2; const f32x4 v = {bflo(w[k]), bfhi(w[k]), bflo(w[k + 1]), bfhi(w[k + 1])}; *(f32x4*)(o0 + 4 * i) = v * rs0 * gv[i]; }
        if (has2) {
#pragma unroll
            for (int i = 0; i < 4; ++i) { const u32x4& w = i < 2 ? b0 : b1; const int k = (i & 1) * 2; const f32x4 v = {bflo(w[k]), bfhi(w[k]), bflo(w[k + 1]), bfhi(w[k + 1])}; *(f32x4*)(o1 + 4 * i) = v * rs1 * gv[i]; } }
    }
}

__device__ __forceinline__ void rot16(const bf16_t* src, bf16_t* dst, const float* cs) {
    const u32x4 a = *(const u32x4*)src, b = *(const u32x4*)(src + 8); const f32x4 c0 = *(const f32x4*)cs, c1 = *(const f32x4*)(cs + 4), s0 = *(const f32x4*)(cs + 8), s1 = *(const f32x4*)(cs + 12);
    float x1[8], x2[8], c[8], s[8];
#pragma unroll
    for (int i = 0; i < 4; ++i) { x1[2 * i] = bflo(a[i]); x1[2 * i + 1] = bfhi(a[i]); x2[2 * i] = bflo(b[i]); x2[2 * i + 1] = bfhi(b[i]); c[i] = c0[i]; c[4 + i] = c1[i]; s[i] = s0[i]; s[4 + i] = s1[i]; }
    u32x4 oa, ob;
#pragma unroll
    for (int i = 0; i < 4; ++i) { oa[i] = pk2(x1[2 * i] * c[2 * i] - x2[2 * i] * s[2 * i], x1[2 * i + 1] * c[2 * i + 1] - x2[2 * i + 1] * s[2 * i + 1]);
                                  ob[i] = pk2(x2[2 * i] * c[2 * i] + x1[2 * i] * s[2 * i], x2[2 * i + 1] * c[2 * i + 1] + x1[2 * i + 1] * s[2 * i + 1]); }
    *(u32x4*)dst = oa; *(u32x4*)(dst + 8) = ob;
}
__device__ __forceinline__ void rot8(bf16_t* p, const float* cs) {
    const u32x4 a = *(const u32x4*)p; const f32x4 c = *(const f32x4*)cs, s = *(const f32x4*)(cs + 4);
    const float x1[4] = {bflo(a[0]), bfhi(a[0]), bflo(a[1]), bfhi(a[1])}, x2[4] = {bflo(a[2]), bfhi(a[2]), bflo(a[3]), bfhi(a[3])};
    u32x4 o; o[0] = pk2(x1[0] * c[0] - x2[0] * s[0], x1[1] * c[1] - x2[1] * s[1]); o[1] = pk2(x1[2] * c[2] - x2[2] * s[2], x1[3] * c[3] - x2[3] * s[3]);
    o[2] = pk2(x2[0] * c[0] + x1[0] * s[0], x2[1] * c[1] + x1[1] * s[1]); o[3] = pk2(x2[2] * c[2] + x1[2] * s[2], x2[3] * c[3] + x1[3] * s[3]);
    *(u32x4*)p = o;
}
__device__ __forceinline__ void rope_even_unit(const Args& a, int u) {
    bf16_t* z = wsb(a, wsm::ACTZ); bf16_t* qr = wsb(a, wsm::QROT); const float* r16 = wsf(a, wsm::ROPE16);
    for (int it = otid(); it < 32 * 18; it += NTHR) { const int tok = u * 32 + it / 18, sl = it % 18; const float* cs = r16 + (size_t)tok * 16;
        if (sl < 12) { const bf16_t* src = z + (size_t)tok * ZLD + E_Q + sl * 64; bf16_t* dst = qr + (size_t)tok * 768 + sl * 64; rot16(src, dst, cs);
#pragma unroll
            for (int i = 2; i < 8; ++i) *(u32x4*)(dst + 8 * i) = *(const u32x4*)(src + 8 * i); }
        else { bf16_t* p = z + (size_t)tok * ZLD + (sl < 15 ? E_KS + (sl - 12) * 64 : E_KW + (sl - 15) * 64); rot16(p, p, cs); } }
}
__device__ __forceinline__ void rope_odd_unit(const Args& a, int u) {
    bf16_t* z = wsb(a, wsm::ACTZ); const float* r16 = wsf(a, wsm::ROPE16); const float* r8 = wsf(a, wsm::ROPE8);
    for (int it = otid(); it < 32 * 30; it += NTHR) { const int tok = u * 32 + it / 30, sl = it % 30; bf16_t* zr = z + (size_t)tok * ZLD;
        if (sl < 25) { const int col = sl < 8 ? O_QC + sl * 64 : (sl == 8 ? O_KC : (sl < 17 ? O_QD + (sl - 9) * 64 : O_KD + (sl - 17) * 64)); rot16(zr + col, zr + col, r16 + (size_t)tok * 16); }
        else { const int col = sl < 29 ? O_QI + (sl - 25) * 32 : O_KI; rot8(zr + col, r8 + (size_t)tok * 8); } }
}

__device__ __forceinline__ void gmlp_unit(const Args& a, int u, ldsp lds) {
    const int tid = otid(), wid = __builtin_amdgcn_readfirstlane(tid >> 6), lane = tid & 63, fr = lane & 15, fq = lane >> 4;
    const bf16_t* z = wsb(a, wsm::ACTZ); bf16_t* mix = wsb(a, wsm::MIX); const int row0 = u * 128;
    constexpr int PIT = 528;
    ldsp U = lds, V = lds + 128 * PIT;
    { const int s = tid >> 2, qd = tid & 3; const bf16_t* zr = z + (size_t)(row0 + s) * ZLD + qd * 64; const float* gn = a.in[12] + qd * 64;
      float vv[64]; float ss = 0.f;
#pragma unroll
      for (int i = 0; i < 8; ++i) { const u32x4 wu = *(const u32x4*)(zr + 8 * i), wv = *(const u32x4*)(zr + 256 + 8 * i); u32x4 ou;
#pragma unroll
          for (int j = 0; j < 4; ++j) { ou[j] = pk2(gelu_tanh(bflo(wu[j])), gelu_tanh(bfhi(wu[j]))); const float v0 = gelu_tanh(bflo(wv[j])), v1 = gelu_tanh(bfhi(wv[j])); vv[8 * i + 2 * j] = v0; vv[8 * i + 2 * j + 1] = v1; ss += v0 * v0 + v1 * v1; }
          *(LAS u32x4*)(U + s * PIT + qd * 128 + i * 16) = ou; }
      ss += __shfl_xor(ss, 1); ss += __shfl_xor(ss, 2);
      const float rs = __builtin_amdgcn_rsqf(ss * (1.0f / 256.0f) + EPS);
#pragma unroll
      for (int i = 0; i < 8; ++i) { const f32x4 g0 = *(const f32x4*)(gn + 8 * i), g1 = *(const f32x4*)(gn + 8 * i + 4); u32x4 ov;
          ov[0] = pk2(vv[8 * i] * rs * g0[0], vv[8 * i + 1] * rs * g0[1]); ov[1] = pk2(vv[8 * i + 2] * rs * g0[2], vv[8 * i + 3] * rs * g0[3]);
          ov[2] = pk2(vv[8 * i + 4] * rs * g1[0], vv[8 * i + 5] * rs * g1[1]); ov[3] = pk2(vv[8 * i + 6] * rs * g1[2], vv[8 * i + 7] * rs * g1[3]);
          *(LAS u32x4*)(V + s * PIT + qd * 128 + i * 16) = ov; } }
    __syncthreads();
    { const bf16_t* W = wsb(a, wsm::SGUW); const float* bias = a.in[14]; const int nks = (16 * wid + 15) / 32 + 1;
#pragma unroll 1
      for (int g = 0; g < 4; ++g) {
          bf16x8 af[4];
#pragma unroll
          for (int ks = 0; ks < 4; ++ks) af[ks] = *(const bf16x8*)(W + ((size_t)g * 128 + 16 * wid + fr) * 128 + 32 * ks + 8 * fq);
#pragma unroll
          for (int dt = 0; dt < 4; ++dt) { f32x4 acc = {0.f, 0.f, 0.f, 0.f}; const int d = g * 64 + dt * 16;
#pragma unroll
              for (int ks = 0; ks < 4; ++ks) if (ks < nks) { ldsp vp = V + (32 * ks + 8 * fq + (fr >> 2)) * PIT + (d + 4 * (fr & 3)) * 2; const s16x4 lo = tr16((const char*)vp), hi = tr16((const char*)(vp + 4 * PIT));
                  const bf16x8 bfr = {lo[0], lo[1], lo[2], lo[3], hi[0], hi[1], hi[2], hi[3]}; acc = MFMA16(af[ks], bfr, acc); }
#pragma unroll
              for (int i = 0; i < 4; ++i) { const int t = 16 * wid + 4 * fq + i; const float uu = bf2f(*(const LAS bf16_t*)(U + t * PIT + (d + fr) * 2)); mix[(size_t)(row0 + t) * 1024 + d + fr] = f2bf(uu * (acc[i] + bias[g * 128 + t])); } }
      } }
    __syncthreads();
}

__device__ __forceinline__ void compress_unit(const Args& a, int u, ldsp lds) {
    const int tid = otid(), wid = __builtin_amdgcn_readfirstlane(tid >> 6), lane = tid & 63, fr = lane & 15, fq = lane >> 4;
    const int nt = u & 7, g = (u >> 3) % 3, b = ((u >> 3) / 3) & 15, kv = (u >> 3) / 48;
    const bf16_t* z = wsb(a, wsm::ACTZ); const bf16_t* w1t = wsb(a, wsm::CW1T + kv * wsm::CW1T_1); const bf16_t* w2t = wsb(a, wsm::CW2T + kv * wsm::CW2T_1);
    LAS float* c1 = (LAS float*)lds; ldsp Hs = lds + 1024; constexpr int PIT = 528;
    if (tid < 256) { const float* p = wsf(a, wsm::C1P) + (size_t)kv * 32 * 256 + tid; float s = 0.f;
#pragma unroll 8
        for (int i = 0; i < 32; ++i) s += p[i * 256]; c1[tid] = s; }
    __syncthreads();
    int n = nt * 16 + fr; if (n > 126) n = 126;
    const bf16_t* ap = z + ((size_t)b * S + 16 * n) * ZLD + (kv ? E_VC : E_KC) + g * 64 + 8 * fq;
    const bf16_t* bp0 = w1t + (size_t)(32 * wid + fr) * 2048 + 8 * fq; const bf16_t* bp1 = bp0 + 16 * 2048;
    f32x4 acc0 = {0.f, 0.f, 0.f, 0.f}, acc1 = {0.f, 0.f, 0.f, 0.f};
#pragma unroll 1
    for (int c8 = 0; c8 < 8; ++c8) {
        bf16x8 af[8], b0[8], b1[8];
#pragma unroll
        for (int j = 0; j < 8; ++j) { const int st = c8 * 8 + j, l = st >> 1, d0 = (st & 1) * 32;
            af[j] = *(const bf16x8*)(ap + (size_t)l * ZLD + d0); b0[j] = *(const bf16x8*)(bp0 + st * 32); b1[j] = *(const bf16x8*)(bp1 + st * 32); }
        __builtin_amdgcn_sched_barrier(0);
#pragma unroll
        for (int j = 0; j < 8; ++j) { acc0 = MFMA16(af[j], b0[j], acc0); acc1 = MFMA16(af[j], b1[j], acc1); }
        __builtin_amdgcn_sched_barrier(0);
    }
#pragma unroll
    for (int i = 0; i < 4; ++i) { const int r = 4 * fq + i, c0 = 32 * wid + fr;
        *(LAS bf16_t*)(Hs + r * PIT + c0 * 2) = f2bf(gelu_tanh(acc0[i] + c1[c0])); *(LAS bf16_t*)(Hs + r * PIT + (c0 + 16) * 2) = f2bf(gelu_tanh(acc1[i] + c1[c0 + 16])); }
    __syncthreads();
    if (wid < 4) { f32x4 acc = {0.f, 0.f, 0.f, 0.f};
#pragma unroll
        for (int ks = 0; ks < 8; ++ks) { const bf16x8 af = *(const LAS bf16x8*)(Hs + fr * PIT + (32 * ks + 8 * fq) * 2), bfr = *(const bf16x8*)(w2t + (size_t)(16 * wid + fr) * 256 + 32 * ks + 8 * fq); acc = MFMA16(af, bfr, acc); }
        bf16_t* o = wsb(a, kv ? wsm::VCMP : wsm::KCMP) + ((size_t)(b * 3 + g) * 128) * 64;
#pragma unroll
        for (int i = 0; i < 4; ++i) { const int nn = nt * 16 + 4 * fq + i; o[(size_t)nn * 64 + 16 * wid + fr] = nn > 126 ? (bf16_t)0 : f2bf(acc[i]); } }
    __syncthreads();
}

struct AttnAcc { f32x16 o0, o1, negm; float l; bool started; float m; };
constexpr float ATT_THR = 8.0f;
#ifndef ATT_OLD
#define ATT_OLD 1
#endif
__device__ __forceinline__ void acc_init(AttnAcc& A) {
#pragma unroll
    for (int r = 0; r < 16; ++r) { A.o0[r] = 0.f; A.o1[r] = 0.f; A.negm[r] = 0.f; }
    A.l = 0.f; A.started = false; A.m = -1e30f; }
__device__ __forceinline__ bf16x8 scale_q(bf16x8 q) { u32x4 w = __builtin_bit_cast(u32x4, q);
#pragma unroll
    for (int i = 0; i < 4; ++i) w[i] = pk2(bflo(w[i]) * C2, bfhi(w[i]) * C2);
    return __builtin_bit_cast(bf16x8, w); }
__device__ __forceinline__ void stage_kv(const bf16_t* Kt, int ldk, const bf16_t* Vt, int ldv, ldsp slot, int wid, int lane) {
    const bf16_t* ks = Kt + (size_t)lane * ldk + wid * 8;
    const bf16_t* vs = Vt + (size_t)(16 * (wid & 3) + (lane >> 2)) * ldv + (wid >> 2) * 32 + (lane & 3) * 8;
    __builtin_amdgcn_global_load_lds((const unsigned*)ks, (LAS unsigned*)(slot + wid * 1024), 16, 0, 0);
    __builtin_amdgcn_global_load_lds((const unsigned*)vs, (LAS unsigned*)(slot + 8192 + wid * 1024), 16, 0, 0);
}
__device__ __forceinline__ void load_kfrags(bf16x8 (&kf)[8], ldsp slot, int lane) {
    ldsp kp = slot + (lane >> 5) * 1024 + (lane & 31) * 16;
#pragma unroll
    for (int d0 = 0; d0 < 4; ++d0) { kf[2 * d0] = *(const LAS bf16x8*)(kp + d0 * 2048); kf[2 * d0 + 1] = *(const LAS bf16x8*)(kp + d0 * 2048 + 512); }
}
__device__ __forceinline__ void pv_tile(f32x16& o0, f32x16& o1, const f32x16& p0, const f32x16& p1, ldsp slot, int lane) {
    const int hi = lane >> 5;
    u32x4 pw[4];
#pragma unroll
    for (int i = 0; i < 4; ++i) { pw[0][i] = pk2(p0[2 * i], p0[2 * i + 1]); pw[1][i] = pk2(p0[8 + 2 * i], p0[9 + 2 * i]); pw[2][i] = pk2(p1[2 * i], p1[2 * i + 1]); pw[3][i] = pk2(p1[8 + 2 * i], p1[9 + 2 * i]); }
    ldsp vp = slot + 8192 + ((lane >> 4) & 1) * 32 + (lane & 3) * 8 + (4 * hi + ((lane & 15) >> 2)) * 64;
#pragma unroll
    for (int s = 0; s < 4; ++s) { const bf16x8 pf = __builtin_bit_cast(bf16x8, pw[s]);
        { const s16x4 lo = tr16((const char*)(vp + s * 1024)), h4 = tr16((const char*)(vp + s * 1024 + 512)); const bf16x8 vf = {lo[0], lo[1], lo[2], lo[3], h4[0], h4[1], h4[2], h4[3]}; o0 = MFMA32(vf, pf, o0); }
        { const s16x4 lo = tr16((const char*)(vp + 4096 + s * 1024)), h4 = tr16((const char*)(vp + 4096 + s * 1024 + 512)); const bf16x8 vf = {lo[0], lo[1], lo[2], lo[3], h4[0], h4[1], h4[2], h4[3]}; o1 = MFMA32(vf, pf, o1); } }
}
#define MX3(a, b, c) __builtin_fmaxf(__builtin_fmaxf((a), (b)), (c))
template <class MF> __device__ __forceinline__ void attn_tile(AttnAcc& A, const bf16x8 (&qr)[4], ldsp slot, int t, const MF& mf, bool masked, int lane) {
    const int hi = lane >> 5;
    bf16x8 kf[8]; load_kfrags(kf, slot, lane);
    f32x16 c0 = MFMA32(kf[0], qr[0], A.negm), c1 = MFMA32(kf[1], qr[0], A.negm);
#pragma unroll
    for (int d0 = 1; d0 < 4; ++d0) { c0 = MFMA32(kf[2 * d0], qr[d0], c0); c1 = MFMA32(kf[2 * d0 + 1], qr[d0], c1); }
    if (masked) {
#pragma unroll
        for (int r = 0; r < 16; ++r) { const int k0 = crow(r, hi); c0[r] = mf.ok(t, k0) ? c0[r] : -INFINITY; c1[r] = mf.ok(t, k0 + 32) ? c1[r] : -INFINITY; }
    }
    float ra = MX3(c0[0], c0[1], c1[0]), rb = MX3(c0[2], c0[3], c1[1]); ra = MX3(ra, c1[2], c1[3]);
#pragma unroll
    for (int r = 4; r < 16; r += 4) { ra = MX3(ra, c0[r], c0[r + 1]); rb = MX3(rb, c0[r + 2], c0[r + 3]); ra = MX3(ra, c1[r], c1[r + 1]); rb = MX3(rb, c1[r + 2], c1[r + 3]); }
    const float rm = swap32_max(__builtin_fmaxf(ra, rb));
#if ATT_OLD
    { const float mn = __builtin_fmaxf(A.m, rm), alpha = __builtin_amdgcn_exp2f(A.m - mn); A.m = mn; float sum = 0.f;
#pragma unroll
      for (int r = 0; r < 16; ++r) { c0[r] = __builtin_amdgcn_exp2f(c0[r] - mn); c1[r] = __builtin_amdgcn_exp2f(c1[r] - mn); sum += c0[r] + c1[r]; }
      A.l = A.l * alpha + sum;
#pragma unroll
      for (int r = 0; r < 16; ++r) { A.o0[r] *= alpha; A.o1[r] *= alpha; } }
#else
    const bool fin = rm > -INFINITY;
    float delta = 0.f;
    if (!A.started) { if (fin) delta = rm; } else if (rm > ATT_THR) delta = rm;
    if (__any(delta != 0.f)) {
        const float alpha = A.started ? __builtin_amdgcn_exp2f(-delta) : 1.0f;
#pragma unroll
        for (int r = 0; r < 16; ++r) { c0[r] -= delta; c1[r] -= delta; A.o0[r] *= alpha; A.o1[r] *= alpha; A.negm[r] -= delta; }
        A.l *= alpha;
    }
    A.started = A.started || fin;
    float s0 = 0.f, s1 = 0.f;
#pragma unroll
    for (int r = 0; r < 16; ++r) { c0[r] = __builtin_amdgcn_exp2f(c0[r]); c1[r] = __builtin_amdgcn_exp2f(c1[r]); s0 += c0[r]; s1 += c1[r]; }
    A.l += s0 + s1;
#endif
    pv_tile(A.o0, A.o1, c0, c1, slot, lane);
}
template <class MF> __device__ __forceinline__ void attn_run(AttnAcc& A, const bf16x8 (&qr)[4], const bf16_t* K, int ldk, const bf16_t* V, int ldv, int tb, int te, MF& mf, ldsp kv, int wid, int lane) {
    if (tb >= te) return;
    stage_kv(K + (size_t)tb * 64 * ldk, ldk, V + (size_t)tb * 64 * ldv, ldv, kv, wid, lane);
    for (int t = tb; t < te; ++t) {
        ldsp cur = kv + ((t - tb) & 1) * 16384, nxt = kv + (((t - tb) & 1) ^ 1) * 16384;
        asm volatile("s_waitcnt vmcnt(0)" ::: "memory"); __syncthreads();
        if (t + 1 < te) stage_kv(K + (size_t)(t + 1) * 64 * ldk, ldk, V + (size_t)(t + 1) * 64 * ldv, ldv, nxt, wid, lane);
        const int kd = mf.prep(t);
        if (kd) attn_tile(A, qr, cur, t, mf, kd == 2, lane);
    }
    __syncthreads();
}
__device__ __forceinline__ float acc_inv(const AttnAcc& A) { const float l = swap32_sum(A.l); return l > 0.f ? __builtin_amdgcn_rcpf(l) : 0.f; }
__device__ __forceinline__ void store_rows(bf16_t* dst  , const f32x16& o0, const f32x16& o1, float sc, int hi) {
#pragma unroll
    for (int gq = 0; gq < 4; ++gq) { u32x2 w0, w1; w0.x = pk2(o0[4 * gq] * sc, o0[4 * gq + 1] * sc); w0.y = pk2(o0[4 * gq + 2] * sc, o0[4 * gq + 3] * sc); w1.x = pk2(o1[4 * gq] * sc, o1[4 * gq + 1] * sc); w1.y = pk2(o1[4 * gq + 2] * sc, o1[4 * gq + 3] * sc);
        *(u32x2*)(dst + 8 * gq + 4 * hi) = w0; *(u32x2*)(dst + 32 + 8 * gq + 4 * hi) = w1; }
}

struct SlcMF { unsigned sel; int jq, trel;
    __device__ __forceinline__ int prep(int t) const { const bool bit = (sel >> t) & 1u; if (!__any(bit)) return 0; return (t < jq && __all(bit)) ? 1 : 2; }
    __device__ __forceinline__ bool ok(int t, int kr) const { return ((sel >> t) & 1u) && (t < jq || kr <= trel); } };
struct WinMF { int jq, trel;
    __device__ __forceinline__ int prep(int t) const { return (t == jq || t == jq - 8) ? 2 : 1; }
    __device__ __forceinline__ bool ok(int t, int kr) const { return t == jq ? kr <= trel : (t == jq - 8 ? kr > trel : true); } };
__device__ __forceinline__ void nsa_unit(const Args& a, int b, int g, int jq, ldsp lds) {
    const int tid = otid(), wid = __builtin_amdgcn_readfirstlane(tid >> 6), lane = tid & 63, r32 = lane & 31, hi = lane >> 5;
    const int ql = r32 >> 2, hr = r32 & 3, trel = wid * 8 + ql, tok = jq * 64 + trel, h = 4 * g + hr; const size_t row = (size_t)b * S + tok;
    const bf16_t* z = wsb(a, wsm::ACTZ); const bf16_t* qrot = wsb(a, wsm::QROT); const bf16_t* zb = z + (size_t)b * S * ZLD;
    ldsp kv = lds; LAS float* psum = (LAS float*)(lds + 32768) + wid * 1024; LAS float* impw = (LAS float*)(lds + 65536) + wid * 256;
    float gate[3];
#pragma unroll
    for (int i = 0; i < 3; ++i) gate[i] = sigmoidf_(bf2f(z[row * ZLD + E_GL + h * 3 + i]));
    f32x16 out0, out1; unsigned sel;
    {
        const bf16_t* Kc = wsb(a, wsm::KCMP) + (size_t)(b * 3 + g) * 128 * 64; const bf16_t* Vc = wsb(a, wsm::VCMP) + (size_t)(b * 3 + g) * 128 * 64;
        stage_kv(Kc, 64, Vc, 64, kv, wid, lane); stage_kv(Kc + 64 * 64, 64, Vc + 64 * 64, 64, kv + 16384, wid, lane);
        asm volatile("s_waitcnt vmcnt(0)" ::: "memory"); __syncthreads();
        f32x16 c[4];
        bf16x8 qn[4];
#pragma unroll
        for (int d0 = 0; d0 < 4; ++d0) qn[d0] = scale_q(*(const bf16x8*)(z + row * ZLD + E_Q + h * 64 + 16 * d0 + 8 * hi));
#pragma unroll
        for (int tt = 0; tt < 2; ++tt) { bf16x8 kf[8]; load_kfrags(kf, kv + tt * 16384, lane);
#pragma unroll
            for (int r = 0; r < 16; ++r) { c[2 * tt][r] = 0.f; c[2 * tt + 1][r] = 0.f; }
#pragma unroll
            for (int d0 = 0; d0 < 4; ++d0) { c[2 * tt] = MFMA32(kf[2 * d0], qn[d0], c[2 * tt]); c[2 * tt + 1] = MFMA32(kf[2 * d0 + 1], qn[d0], c[2 * tt + 1]); } }
        float rm = -1e30f;
#pragma unroll
        for (int q = 0; q < 4; ++q)
#pragma unroll
            for (int r = 0; r < 16; ++r) { const int n = 32 * q + crow(r, hi); const float v = (16 * n + 31 <= tok) ? c[q][r] : -INFINITY; c[q][r] = v; rm = __builtin_fmaxf(rm, v); }
        rm = swap32_max(rm); float sum = 0.f;
#pragma unroll
        for (int q = 0; q < 4; ++q)
#pragma unroll
            for (int r = 0; r < 16; ++r) { const float p = __builtin_amdgcn_exp2f(c[q][r] - rm); c[q][r] = p; sum += p; }
        sum = swap32_sum(sum); const float inv = sum > 0.f ? __builtin_amdgcn_rcpf(sum) : 0.f;
#pragma unroll
        for (int q = 0; q < 4; ++q)
#pragma unroll
            for (int r = 0; r < 16; ++r) c[q][r] *= inv;
#pragma unroll
        for (int r = 0; r < 16; ++r) { out0[r] = 0.f; out1[r] = 0.f; }
        pv_tile(out0, out1, c[0], c[1], kv, lane); pv_tile(out0, out1, c[2], c[3], kv + 16384, lane);
#pragma unroll
        for (int r = 0; r < 16; ++r) { out0[r] *= gate[0]; out1[r] *= gate[0]; }
#pragma unroll
        for (int q = 0; q < 4; ++q)
#pragma unroll
            for (int r = 0; r < 16; ++r) { float v = c[q][r]; v += __shfl_xor(v, 1); v += __shfl_xor(v, 2); if (hr == 0) psum[(32 * q + crow(r, hi)) * 8 + ql] = v; }
        asm volatile("s_waitcnt lgkmcnt(0)" ::: "memory");
        { const int q = lane & 7, jj = lane >> 3; float val[4];
#pragma unroll
          for (int k = 0; k < 4; ++k) { const int j = jj + 8 * k; float s = 0.f;
#pragma unroll
              for (int n = 4 * j - 1; n <= 4 * j + 3; ++n) if (n >= 0) s += psum[n * 8 + q];
              const bool adm = j <= jq, forced = (j == 0) || (j == jq); val[k] = adm ? (forced ? 1e4f : s) : -1e30f; impw[q * 32 + j] = val[k]; }
          asm volatile("s_waitcnt lgkmcnt(0)" ::: "memory");
          int rank[4] = {0, 0, 0, 0};
#pragma unroll
          for (int j4 = 0; j4 < 8; ++j4) { const f32x4 o = *(const LAS f32x4*)(impw + q * 32 + 4 * j4);
#pragma unroll
              for (int e = 0; e < 4; ++e) { const int jo = 4 * j4 + e;
#pragma unroll
                  for (int k = 0; k < 4; ++k) { const int j = jj + 8 * k; rank[k] += (o[e] > val[k] || (o[e] == val[k] && jo < j)) ? 1 : 0; } } }
          unsigned bits = 0u;
#pragma unroll
          for (int k = 0; k < 4; ++k) { const int j = jj + 8 * k; if (j <= jq && rank[k] < 8) bits |= 1u << j; }
          bits |= __shfl_xor(bits, 8); bits |= __shfl_xor(bits, 16); bits |= __shfl_xor(bits, 32);
          sel = __shfl(bits, ql); }
        __syncthreads();
    }
    bf16x8 qr[4];
#pragma unroll
    for (int d0 = 0; d0 < 4; ++d0) qr[d0] = scale_q(*(const bf16x8*)(qrot + row * 768 + h * 64 + 16 * d0 + 8 * hi));
    { AttnAcc A; acc_init(A); SlcMF mf{sel, jq, trel};
      attn_run(A, qr, zb + E_KS + g * 64, ZLD, zb + E_VS + g * 64, ZLD, 0, jq + 1, mf, kv, wid, lane);
      const float sc = acc_inv(A) * gate[1];
#pragma unroll
      for (int r = 0; r < 16; ++r) { out0[r] += A.o0[r] * sc; out1[r] += A.o1[r] * sc; } }
    { AttnAcc A; acc_init(A); WinMF mf{jq, trel};
      attn_run(A, qr, zb + E_KW + g * 64, ZLD, zb + E_VW + g * 64, ZLD, jq >= 8 ? jq - 8 : 0, jq + 1, mf, kv, wid, lane);
      const float sc = acc_inv(A) * gate[2];
#pragma unroll
      for (int r = 0; r < 16; ++r) { out0[r] += A.o0[r] * sc; out1[r] += A.o1[r] * sc; } }
    store_rows(wsb(a, wsm::MIX) + row * 1024 + 256 + h * 64, out0, out1, 1.0f, hi);
}

__device__ __forceinline__ unsigned order_key(float f) { unsigned u = __float_as_uint(f); if ((u << 1) == 0u) u = 0u; return u ^ ((u >> 31) ? 0xFFFFFFFFu : 0x80000000u); }
__device__ __forceinline__ float key_val(unsigned k) { return __uint_as_float(k >= 0x80000000u ? (k ^ 0x80000000u) : ~k); }
__device__ __forceinline__ unsigned xq_sum(unsigned c, LAS unsigned* buf, int par, int wid, int fr, int fq) {
    c += __shfl_xor(c, 16); c += __shfl_xor(c, 32);
    if (fq == 0) buf[par * 128 + wid * 16 + fr] = c;
    asm volatile("s_waitcnt lgkmcnt(0)" ::: "memory"); __syncthreads();
    unsigned r = 0u;
#pragma unroll
    for (int w = 0; w < 8; ++w) r += buf[par * 128 + w * 16 + fr];
    return r;
}
__device__ __forceinline__ void xq_4(unsigned& s0, unsigned& s1, unsigned& mx, unsigned& mn, LAS unsigned* buf, int wid, int fr, int fq) {
    s0 += __shfl_xor(s0, 16); s0 += __shfl_xor(s0, 32); s1 += __shfl_xor(s1, 16); s1 += __shfl_xor(s1, 32);
    { unsigned o = __shfl_xor(mx, 16); mx = mx > o ? mx : o; o = __shfl_xor(mx, 32); mx = mx > o ? mx : o; o = __shfl_xor(mn, 16); mn = mn < o ? mn : o; o = __shfl_xor(mn, 32); mn = mn < o ? mn : o; }
    if (fq == 0) { buf[wid * 64 + fr] = s0; buf[wid * 64 + 16 + fr] = s1; buf[wid * 64 + 32 + fr] = mx; buf[wid * 64 + 48 + fr] = mn; }
    asm volatile("s_waitcnt lgkmcnt(0)" ::: "memory"); __syncthreads();
    s0 = 0u; s1 = 0u; mx = 0u; mn = 0xFFFFFFFFu;
#pragma unroll
    for (int w = 0; w < 8; ++w) { s0 += buf[w * 64 + fr]; s1 += buf[w * 64 + 16 + fr]; const unsigned a = buf[w * 64 + 32 + fr], b = buf[w * 64 + 48 + fr]; mx = mx > a ? mx : a; mn = mn < b ? mn : b; }
}
__device__ __forceinline__ void dsa_select_unit(const Args& a, int b, int qt, ldsp lds) {
    const int tid = otid(), wid = __builtin_amdgcn_readfirstlane(tid >> 6), lane = tid & 63, fr = lane & 15, fq = lane >> 4;
    const bf16_t* zb = wsb(a, wsm::ACTZ) + (size_t)b * S * ZLD; const int t0 = qt * 16, t = t0 + fr; const int nW = (t0 + 15) / 32 + 1;
    LAS unsigned* cbuf = (LAS unsigned*)lds;
    LAS unsigned* xbuf = (LAS unsigned*)(lds + 1024);
    bf16x8 bq[4]; float wq[4];
#pragma unroll
    for (int h = 0; h < 4; ++h) { bq[h] = *(const bf16x8*)(zb + (size_t)t * ZLD + O_QI + h * 32 + 8 * fq); wq[h] = bf2f(zb[(size_t)t * ZLD + O_WI + h]); }
    SUBT_BEGIN(1);
    unsigned U[8][8];
    const int trel = t - 4 * fq;
#pragma unroll
    for (int kh4 = 0; kh4 < 2; ++kh4) { bf16x8 af[4][2];
#pragma unroll
      for (int k4 = 0; k4 < 4; ++k4)
#pragma unroll
          for (int hf = 0; hf < 2; ++hf) { const int word = wid + 8 * (4 * kh4 + k4); const int kb = word < nW ? 32 * word + 16 * hf : 0; af[k4][hf] = *(const bf16x8*)(zb + (size_t)(kb + fr) * ZLD + O_KI + 8 * fq); }
#pragma unroll
      for (int k4 = 0; k4 < 4; ++k4) { const int k = 4 * kh4 + k4, word = wid + 8 * k;
#pragma unroll
          for (int hf = 0; hf < 2; ++hf) { const int kb = 32 * word + 16 * hf;
              f32x4 sc = {0.f, 0.f, 0.f, 0.f};
#pragma unroll
              for (int h = 0; h < 4; ++h) { const f32x4 zero = {0.f, 0.f, 0.f, 0.f}; const f32x4 cc = MFMA16(af[k4][hf], bq[h], zero);
#pragma unroll
                  for (int i = 0; i < 4; ++i) sc[i] += wq[h] * __builtin_fmaxf(cc[i], 0.f); }
#pragma unroll
              for (int i = 0; i < 4; ++i) { U[k][4 * hf + i] = (word < nW && kb + i <= trel) ? order_key(sc[i]) : 0u; asm volatile("" : "+v"(U[k][4 * hf + i])); } }
          __builtin_amdgcn_sched_barrier(0); }
      __builtin_amdgcn_sched_barrier(0); }
#ifdef PROBE_SUB
    if (PROBE_SUB == 20) {
        bool bad = false;
#pragma unroll
        for (int k = 0; k < 8; ++k)
#pragma unroll
          for (int ii = 1; ii < 8; ii += 5) { const int word = wid + 8 * k, key = 32 * word + 16 * (ii >> 2) + 4 * fq + (ii & 3);
            if (word < nW && key <= t) { float sc = 0.f;
                for (int h = 0; h < 4; ++h) { float lg = 0.f; for (int d = 0; d < 32; ++d) lg += bf2f(zb[(size_t)t * ZLD + O_QI + h * 32 + d]) * bf2f(zb[(size_t)key * ZLD + O_KI + d]); sc += wq[h] * __builtin_fmaxf(lg, 0.f); }
                const float got = key_val(U[k][ii]); if (!(__builtin_fabsf(got - sc) <= 1e-3f * (1.0f + __builtin_fabsf(sc)))) bad = true; } }
        if (__any(bad) && (threadIdx.x & 63) == 0) __hip_atomic_fetch_add((LAS unsigned*)(lds + cfg::LDS_BYTES - 8), 10000u, __ATOMIC_RELAXED, __HIP_MEMORY_SCOPE_WORKGROUP);
    }
#endif
    SUBT_END(1, lds); SUBT_BEGIN(2);
#define DSA_CNT(EXPR, OUT) do { unsigned c_ = 0u; _Pragma("unroll") for (int k = 0; k < 8; ++k) if (wid + 8 * k < nW) { _Pragma("unroll") for (int i = 0; i < 8; ++i) { const unsigned u = U[k][i]; \
        const int kc = 32 * (wid + 8 * k) + 16 * (i >> 2) + (i & 3); (void)kc; (void)u; c_ += (EXPR) ? 1u : 0u; } } OUT = c_; } while (0)
    unsigned T = 0u; int I = 2047;
    if (t0 + 16 > 256) {
        const bool need = t >= 256;
        unsigned cge, cgt, kmx = 0u, kmn = 0xFFFFFFFFu;
        DSA_CNT(u >= 0x80000000u, cge); DSA_CNT(u > 0x80000000u, cgt);
#pragma unroll
        for (int k = 0; k < 8; ++k)
#pragma unroll
            for (int i = 0; i < 8; ++i) { const unsigned u = U[k][i]; kmx = u > kmx ? u : kmx; kmn = (u != 0u && u < kmn) ? u : kmn; }
        xq_4(cge, cgt, kmx, kmn, xbuf, wid, fr, fq);
        unsigned kl = 0u, kh = 2u, cl = 257u, ch = 0u; bool done = !need, tie = false;
        if (!need) {}
        else if (cgt >= 256u) { kl = 0x80000001u; cl = cgt; kh = kmx + 1u; ch = 0u; if (cgt == 256u) { T = kl; done = true; } }
        else if (cge >= 256u) { kl = 0x80000000u; cl = cge; kh = 0x80000001u; ch = cgt; if (cge == 256u) { T = kl; done = true; } }
        else { kl = kmn; cl = (unsigned)(t + 1); kh = 0x80000000u; ch = cge; }
        if (!done && kh - kl == 1u) { T = kl; tie = true; done = true; }
        int fre = !need ? 0 : (kl == 0x80000001u ? 1 : (kh == 0x80000000u ? 2 : 0)), side = 0, it = 0;
        float rl = (float)cl - 256.0f, rh = (float)ch - 256.0f;
#ifndef SEL_CAND
#define SEL_CAND 32u
#endif
        while (!__all(done || (cl - ch) <= SEL_CAND)) {
            unsigned km; const unsigned mid = kl + ((kh - kl) >> 1);
            if (fre == 1) km = (kh - kl > 0x01000000u) ? kh - 0x01000000u : mid;
            else if (fre == 2) km = (kh - kl > 0x01000000u) ? kl + 0x01000000u : mid;
            else km = kl + (unsigned)((float)(kh - kl) * (rl / (rl - rh)));
            km = km <= kl ? kl + 1u : km; km = km >= kh ? kh - 1u : km;
            unsigned c; DSA_CNT(u >= km, c); c = xq_sum(c, cbuf, it & 1, wid, fr, fq);
            if (!done) { if (c == 256u) { T = km; done = true; }
                else if (c > 256u) { kl = km; cl = c; rl = (float)c - 256.0f; if (fre == 1) { fre = 0; side = 0; } else { if (side == 1) rh *= 0.5f; side = 1; } }
                else { kh = km; ch = c; rh = (float)c - 256.0f; if (fre == 2) { fre = 0; side = 0; } else { if (side == 2) rl *= 0.5f; side = 2; } }
                if (!done && kh - kl == 1u) { T = kl; tie = true; done = true; } }
            ++it;
        }
#ifdef PROBE_SUB
        if (PROBE_SUB == 7 && threadIdx.x == 0) *(LAS unsigned*)(lds + cfg::LDS_BYTES - 8) += (unsigned)it * 100u;
#endif
        if (!__all(done)) {
            LAS unsigned* lcnt = (LAS unsigned*)(lds + 4096); LAS unsigned* linf = lcnt + 16; LAS unsigned* lres = linf + 64; LAS unsigned* list = (LAS unsigned*)(lds + 8192);
            __syncthreads();
            if (wid == 0 && fq == 0) { lcnt[fr] = 0u; linf[fr * 4 + 2] = 256u - ch; linf[fr * 4 + 3] = done ? 0u : 1u; lres[fr * 4 + 3] = 0u; }
            __syncthreads();
            { const bool act = !done;
#pragma unroll
              for (int k = 0; k < 8; ++k) if (wid + 8 * k < nW) {
#pragma unroll
                  for (int i = 0; i < 8; ++i) { const unsigned u = U[k][i]; const bool inb = act && u >= kl && u < kh;
                      if (__any(inb)) { if (inb) { const unsigned pos = __hip_atomic_fetch_add(lcnt + fr, 1u, __ATOMIC_RELAXED, __HIP_MEMORY_SCOPE_WORKGROUP); if (pos < 32u) list[fr * 32 + pos] = u; } } } } }
            asm volatile("s_waitcnt lgkmcnt(0)" ::: "memory"); __syncthreads();
            { const int q = tid >> 5, j = tid & 31; const unsigned n = lcnt[q] < 32u ? lcnt[q] : 32u;
              if (linf[q * 4 + 3] != 0u && (unsigned)j < n) { const unsigned rn = linf[q * 4 + 2], v = list[q * 32 + j]; unsigned gt = 0u, eq = 0u;
                  for (unsigned i = 0; i < n; ++i) { const unsigned w = list[q * 32 + i]; gt += w > v ? 1u : 0u; eq += w == v ? 1u : 0u; }
                  if (gt < rn && rn <= gt + eq) { lres[q * 4 + 0] = v; lres[q * 4 + 1] = gt; lres[q * 4 + 2] = eq; lres[q * 4 + 3] = 1u; } } }
            asm volatile("s_waitcnt lgkmcnt(0)" ::: "memory"); __syncthreads();
            if (!done) { T = lres[fr * 4 + 0]; ch += lres[fr * 4 + 1]; tie = lres[fr * 4 + 2] > 256u - ch; done = true; }
            __syncthreads();
        }
        const unsigned budget = 256u - ch;
        if (__any(tie)) { __syncthreads(); int lo = 0;
            for (int bit = 10; bit >= 0; --bit) { const int cand = lo | (1 << bit), crel = cand - 4 * fq; unsigned c; DSA_CNT(u == T && kc < crel, c); c = xq_sum(c, cbuf, bit & 1, wid, fr, fq); if (c < budget) lo = cand; }
            if (tie) I = lo; }
    }
#undef DSA_CNT
    SUBT_END(2, lds); SUBT_BEGIN(3);
    unsigned* mw = (unsigned*)(a.ws + wsm::DMASK) + ((size_t)b * S + t) * 64; const int Irel = I - 4 * fq;
#ifdef PROBE_SUB
    unsigned chk_pop = 0u;
#endif
#pragma unroll
    for (int k = 0; k < 8; ++k) { unsigned bits = 0u;
#pragma unroll
        for (int i = 0; i < 8; ++i) { const unsigned u = U[k][i]; const int kc = 32 * (wid + 8 * k) + 16 * (i >> 2) + (i & 3); const bool sl = (u != 0u) && (u > T || (u == T && kc <= Irel)); bits |= sl ? (1u << (16 * (i >> 2) + (i & 3))) : 0u; }
        bits <<= 4 * fq; bits |= __shfl_xor(bits, 16); bits |= __shfl_xor(bits, 32);
#ifdef PROBE_SUB
        if (PROBE_SUB == 8 && fq == 0) chk_pop += (unsigned)__popc(bits);
#endif
        if (fq == 0) mw[wid + 8 * k] = bits; }
    __syncthreads();
#ifdef PROBE_SUB
    if (PROBE_SUB == 8) {
        const unsigned tot = xq_sum(chk_pop, cbuf, 0, wid, fr, fq), want = (unsigned)(t + 1 < 256 ? t + 1 : 256);
        if (__any(tot != want) && threadIdx.x == 0) *(LAS unsigned*)(lds + cfg::LDS_BYTES - 8) += 10000u;
        __syncthreads(); }
#endif
    SUBT_END(3, lds);
}
__device__ __forceinline__ void kmean_unit(const Args& a, int u, ldsp lds) {
    const int tid = otid(), wid = tid >> 6, lane = tid & 63, b = u >> 3, j = u & 7; const bf16_t* p = wsb(a, wsm::ACTZ) + ((size_t)b * S + j * 256 + wid * 32) * ZLD + O_KD + lane * 8;
    float s[8] = {0.f, 0.f, 0.f, 0.f, 0.f, 0.f, 0.f, 0.f};
#pragma unroll 8
    for (int r = 0; r < 32; ++r) { const u32x4 w = *(const u32x4*)(p + (size_t)r * ZLD);
#pragma unroll
        for (int i = 0; i < 4; ++i) { s[2 * i] += bflo(w[i]); s[2 * i + 1] += bfhi(w[i]); } }
    LAS float* red = (LAS float*)lds;
#pragma unroll
    for (int i = 0; i < 8; ++i) red[wid * 512 + lane * 8 + i] = s[i];
    __syncthreads();
    { float t = 0.f;
#pragma unroll
      for (int w = 0; w < 8; ++w) t += red[w * 512 + tid];
      wsf(a, wsm::KMEAN)[((size_t)(b * 8 + (tid >> 6)) * 8 + j) * 64 + (tid & 63)] = t * (1.0f / 256.0f); }
    __syncthreads();
}

struct DsaMF { const unsigned* mw; unsigned w0, w1, n0, n1;
    __device__ __forceinline__ int prep(int t) { w0 = n0; w1 = n1; if (t < 31) { n0 = mw[2 * t + 2]; n1 = mw[2 * t + 3]; } return __any((w0 | w1) != 0u) ? 2 : 0; }
    __device__ __forceinline__ bool ok(int, int kr) const { return (((kr & 32) ? w1 : w0) >> (kr & 31)) & 1u; } };
__device__ __forceinline__ void dsa_attn_unit(const Args& a, int b, int qt, ldsp lds) {
    const int tid = otid(), wid = __builtin_amdgcn_readfirstlane(tid >> 6), lane = tid & 63, r32 = lane & 31, hi = lane >> 5;
    const int q0 = qt * 32, tok = q0 + r32; const size_t row = (size_t)b * S + tok; const bf16_t* z = wsb(a, wsm::ACTZ); const bf16_t* zb = z + (size_t)b * S * ZLD;
    bf16x8 qr[4];
#pragma unroll
    for (int d0 = 0; d0 < 4; ++d0) qr[d0] = scale_q(*(const bf16x8*)(z + row * ZLD + O_QC + wid * 64 + 16 * d0 + 8 * hi));
    const unsigned* mwp = (const unsigned*)(a.ws + wsm::DMASK) + row * 64; AttnAcc A; acc_init(A); DsaMF mf{mwp, 0u, 0u, mwp[0], mwp[1]};
    attn_run(A, qr, zb + O_KC, ZLD, zb + O_VC, ZLD, 0, q0 / 64 + 1, mf, lds, wid, lane);
    store_rows(wsb(a, wsm::MIX) + row * 1024 + wid * 64, A.o0, A.o1, acc_inv(A), hi);
}

struct MobaMF { unsigned sel; int own, wq, r32;
    __device__ __forceinline__ int prep(int t) const { const int jb = t >> 2;
        if (jb < own) { const bool bit = (sel >> jb) & 1u; if (!__any(bit)) return 0; return __all(bit) ? 1 : 2; }
        const int k0 = 64 * (t - 4 * own); if (k0 > wq + 31) return 0; return (k0 + 63 <= wq) ? 1 : 2; }
    __device__ __forceinline__ bool ok(int t, int kr) const { const int jb = t >> 2; return jb < own ? ((sel >> jb) & 1u) : (64 * (t - 4 * own) + kr <= wq + r32); } };
__device__ __forceinline__ void moba_unit(const Args& a, int b, int h, int own, ldsp lds) {
    const int tid = otid(), wid = __builtin_amdgcn_readfirstlane(tid >> 6), lane = tid & 63, r32 = lane & 31, hi = lane >> 5;
    const int tok = own * 256 + wid * 32 + r32; const size_t row = (size_t)b * S + tok; const bf16_t* z = wsb(a, wsm::ACTZ); const bf16_t* zb = z + (size_t)b * S * ZLD;
    bf16x8 qr[4];
#pragma unroll
    for (int d0 = 0; d0 < 4; ++d0) qr[d0] = scale_q(*(const bf16x8*)(z + row * ZLD + O_QD + h * 64 + 16 * d0 + 8 * hi));
    float gt[7]; const float* km = wsf(a, wsm::KMEAN) + (size_t)(b * 8 + h) * 8 * 64;
#pragma unroll
    for (int j = 0; j < 7; ++j) { float s = 0.f;
        if (j < own) {
#pragma unroll
            for (int d0 = 0; d0 < 4; ++d0) { const f32x4 k0 = *(const f32x4*)(km + j * 64 + 16 * d0 + 8 * hi), k1 = *(const f32x4*)(km + j * 64 + 16 * d0 + 8 * hi + 4); const u32x4 qw = __builtin_bit_cast(u32x4, qr[d0]);
                s += bflo(qw[0]) * k0[0] + bfhi(qw[0]) * k0[1] + bflo(qw[1]) * k0[2] + bfhi(qw[1]) * k0[3] + bflo(qw[2]) * k1[0] + bfhi(qw[2]) * k1[1] + bflo(qw[3]) * k1[2] + bfhi(qw[3]) * k1[3]; }
            s = swap32_sum(s); }
        gt[j] = s; }
    unsigned sel = 0u;
#pragma unroll
    for (int j = 0; j < 7; ++j) { int rank = 0;
#pragma unroll
        for (int j2 = 0; j2 < 7; ++j2) rank += (j2 < own && j2 != j && (gt[j2] > gt[j] || (gt[j2] == gt[j] && j2 < j))) ? 1 : 0;
        if (j < own && rank < 3) sel |= 1u << j; }
    AttnAcc A; acc_init(A); MobaMF mf{sel, own, wid * 32, r32};
    attn_run(A, qr, zb + O_KD + h * 64, ZLD, zb + O_VD + h * 64, ZLD, 0, 4 * own + 4, mf, lds, wid, lane);
    store_rows(wsb(a, wsm::MIX) + row * 1024 + 512 + h * 64, A.o0, A.o1, acc_inv(A), hi);
}
}
#ifdef PROBE_SUB
namespace chk {
#ifndef CHK_TOL
#define CHK_TOL 1e-3f
#endif
using namespace cfg;
typedef LAS char* ldsp;
__device__ __forceinline__ float wave_max(float v) { for (int o = 32; o >= 1; o >>= 1) v = __builtin_fmaxf(v, __shfl_xor(v, o)); return v; }
__device__ __forceinline__ float wave_sum(float v) { for (int o = 32; o >= 1; o >>= 1) v += __shfl_xor(v, o); return v; }
__device__ __forceinline__ float dot64(const bf16_t* a, const bf16_t* b) { float s = 0.f; for (int d = 0; d < 64; ++d) s += bf2f(a[d]) * bf2f(b[d]); return s; }
__device__ __forceinline__ unsigned hash32(unsigned x) { x ^= x >> 16; x *= 0x7feb352dU; x ^= x >> 15; x *= 0x846ca68bU; x ^= x >> 16; return x; }
__device__ __forceinline__ void flag_bad(ldsp lds, bool bad, int cls) { if ((PROBE_SUB == cls || (PROBE_SUB == 12 && cls == 9)) && __any(bad) && (threadIdx.x & 63) == 0) __hip_atomic_fetch_add((LAS unsigned*)(lds + LDS_BYTES - 8), 10000u, __ATOMIC_RELAXED, __HIP_MEMORY_SCOPE_WORKGROUP); }
__device__ __forceinline__ bool differs(float got, float ref) { return !(__builtin_fabsf(got - ref) <= 0.004f + 0.03f * __builtin_fabsf(ref)); }
template <class OK> __device__ __forceinline__ float naive_attn(const bf16_t* q, const bf16_t* K, int ldk, const bf16_t* V, int ldv, int nkeys, int d0, const OK& ok, int lane) {
    float m = -INFINITY;
    for (int s = lane; s < nkeys; s += 64) if (ok(s)) m = __builtin_fmaxf(m, 0.125f * dot64(q, K + (size_t)s * ldk));
    m = wave_max(m); if (!(m > -INFINITY)) return 0.f;
    float l = 0.f, o = 0.f;
    for (int s = lane; s < nkeys; s += 64) if (ok(s)) { const float p = __expf(0.125f * dot64(q, K + (size_t)s * ldk) - m); l += p; o += p * bf2f(V[(size_t)s * ldv + d0]); }
    l = wave_sum(l); o = wave_sum(o); return o / l;
}
struct DsaOk { const unsigned* mw; int t; __device__ __forceinline__ bool operator()(int s) const { return s <= t && ((mw[s >> 5] >> (s & 31)) & 1u); } };
struct MobaOk { unsigned sel; int own, t; __device__ __forceinline__ bool operator()(int s) const { const int j = s >> 8; return j < own ? ((sel >> j) & 1u) : (j == own && s <= t); } };
__device__ __forceinline__ void check_odd(const Args& a, ldsp lds, int mode) {
    const int tid_ = ph::otid(), lane = tid_ & 63, wv = blockIdx.x * 8 + (tid_ >> 6); const bf16_t* z = ph::wsb(a, wsm::ACTZ); const bf16_t* mix = ph::wsb(a, wsm::MIX);
    for (int rep = 0; rep < 2; ++rep) { const unsigned hsh = hash32((unsigned)(wv * 4 + rep) * 2654435761u + 12345u); const int b = hsh & 15, t = (hsh >> 4) & 2047, h = (hsh >> 15) & 7, d0 = ((hsh >> 18) + (mode == 12 ? 1 : 0)) & 63;
        const size_t row = (size_t)b * S + t; const bf16_t* zb = z + (size_t)b * S * ZLD;
        {
          const unsigned* mw = (const unsigned*)(a.ws + wsm::DMASK) + row * 64; DsaOk ok{mw, t};
          const float ref = naive_attn(z + row * ZLD + O_QC + h * 64, zb + O_KC, ZLD, zb + O_VC, ZLD, t + 1, d0, ok, lane);
          flag_bad(lds, differs(bf2f(mix[row * 1024 + h * 64 + d0]), ref), 9);
          float mn_sel = INFINITY, mx_uns = -INFINITY; int cnt = 0;
          for (int s = lane; s <= t; s += 64) { float sc = 0.f;
              for (int hh = 0; hh < 4; ++hh) { float lg = 0.f; for (int d = 0; d < 32; ++d) lg += bf2f(z[row * ZLD + O_QI + hh * 32 + d]) * bf2f(zb[(size_t)s * ZLD + O_KI + d]); sc += bf2f(z[row * ZLD + O_WI + hh]) * __builtin_fmaxf(lg, 0.f); }
              if ((mw[s >> 5] >> (s & 31)) & 1u) { mn_sel = __builtin_fminf(mn_sel, sc); ++cnt; } else mx_uns = __builtin_fmaxf(mx_uns, sc); }
          mn_sel = -wave_max(-mn_sel); mx_uns = wave_max(mx_uns); cnt = (int)wave_sum((float)cnt);
          const bool badcnt = cnt != (t + 1 < 256 ? t + 1 : 256), badord = (mx_uns > -INFINITY && mn_sel < mx_uns - CHK_TOL * (1.0f + __builtin_fabsf(mx_uns)));
          flag_bad(lds, badcnt || badord, 10); flag_bad(lds, badcnt, 16); flag_bad(lds, badord && t >= 600, 18); flag_bad(lds, badord && t < 600, 19); }
        {
          const int own = t >> 8; const float* km = ph::wsf(a, wsm::KMEAN) + (size_t)(b * 8 + h) * 8 * 64; const bf16_t* q = z + row * ZLD + O_QD + h * 64; float gt[7];
#pragma unroll
          for (int j = 0; j < 7; ++j) { float s = 0.f; if (j < own) for (int d = 0; d < 64; ++d) s += bf2f(q[d]) * km[j * 64 + d]; gt[j] = s; }
          unsigned sel = 0u;
#pragma unroll
          for (int j = 0; j < 7; ++j) { int rank = 0;
#pragma unroll
              for (int j2 = 0; j2 < 7; ++j2) rank += (j2 < own && j2 != j && (gt[j2] > gt[j] || (gt[j2] == gt[j] && j2 < j))) ? 1 : 0;
              if (j < own && rank < 3) sel |= 1u << j; }
          MobaOk ok{sel, own, t};
          const float ref = naive_attn(q, zb + O_KD + h * 64, ZLD, zb + O_VD + h * 64, ZLD, t + 1, d0, ok, lane);
          flag_bad(lds, differs(bf2f(mix[row * 1024 + 512 + h * 64 + d0]), ref), 11); }
    }
}
struct SlcOk { unsigned sel; int t; __device__ __forceinline__ bool operator()(int s) const { return s <= t && ((sel >> (s >> 6)) & 1u); } };
struct WinOk { int t; __device__ __forceinline__ bool operator()(int s) const { return s <= t && s > t - 512; } };
struct CmpOk { int t; __device__ __forceinline__ bool operator()(int n) const { return n < 127 && 16 * n + 31 <= t; } };
__device__ __forceinline__ void check_even(const Args& a, ldsp lds, int mode) {
    const int tid_ = ph::otid(), lane = tid_ & 63, wid = tid_ >> 6, wv = blockIdx.x * 8 + wid; const bf16_t* z = ph::wsb(a, wsm::ACTZ); const bf16_t* mix = ph::wsb(a, wsm::MIX); const bf16_t* qrot = ph::wsb(a, wsm::QROT);
    LAS float* ps = (LAS float*)(lds + 4096) + wid * 160;
    for (int rep = 0; rep < 2; ++rep) { const unsigned hsh = hash32((unsigned)(wv * 4 + rep) * 2246822519u + 777u); const int b = hsh & 15, t = (hsh >> 4) & 2047, h = ((hsh >> 15) & 15) % 12, d0 = ((hsh >> 19) + (mode == 12 ? 1 : 0)) & 63, g = h >> 2;
        const size_t row = (size_t)b * S + t; const bf16_t* zb = z + (size_t)b * S * ZLD; const bf16_t* Kc = ph::wsb(a, wsm::KCMP) + (size_t)(b * 3 + g) * 128 * 64; const bf16_t* Vc = ph::wsb(a, wsm::VCMP) + (size_t)(b * 3 + g) * 128 * 64;
        float p0 = 0.f, p1 = 0.f; CmpOk cok{t};
        for (int r = 0; r < 4; ++r) { const bf16_t* qn = z + row * ZLD + E_Q + (4 * g + r) * 64; const float s0 = cok(lane) ? 0.125f * dot64(qn, Kc + (size_t)lane * 64) : -INFINITY, s1 = cok(lane + 64) ? 0.125f * dot64(qn, Kc + (size_t)(lane + 64) * 64) : -INFINITY;
            const float m = wave_max(__builtin_fmaxf(s0, s1)); if (m > -INFINITY) { const float e0 = __expf(s0 - m), e1 = __expf(s1 - m), l = wave_sum(e0 + e1); p0 += e0 / l; p1 += e1 / l; } }
        ps[lane] = p0; ps[lane + 64] = p1; asm volatile("s_waitcnt lgkmcnt(0)" ::: "memory");
        const int jq = t >> 6;
        if (lane < 32) { const int j = lane; float s = 0.f; for (int n = 4 * j - 1; n <= 4 * j + 3; ++n) if (n >= 0 && n < 128) s += ps[n]; ps[128 + j] = j <= jq ? ((j == 0 || j == jq) ? 1e4f : s) : -1e30f; }
        asm volatile("s_waitcnt lgkmcnt(0)" ::: "memory");
        bool mine = false; if (lane < 32) { const float v = ps[128 + lane]; int rank = 0; for (int j2 = 0; j2 < 32; ++j2) { const float o = ps[128 + j2]; rank += (o > v || (o == v && j2 < lane)) ? 1 : 0; } mine = lane <= jq && rank < 8; }
        const unsigned sel = (unsigned)__ballot(mine);
        const bf16_t* qn = z + row * ZLD + E_Q + h * 64; const bf16_t* qr = qrot + row * 768 + h * 64;
        const float oc = naive_attn(qn, Kc, 64, Vc, 64, 128, d0, cok, lane);
        SlcOk sok{sel, t}; const float os = naive_attn(qr, zb + E_KS + g * 64, ZLD, zb + E_VS + g * 64, ZLD, t + 1, d0, sok, lane);
        WinOk wok{t}; const float ow = naive_attn(qr, zb + E_KW + g * 64, ZLD, zb + E_VW + g * 64, ZLD, t + 1, d0, wok, lane);
        const float g0_ = 1.0f / (1.0f + __expf(-bf2f(z[row * ZLD + E_GL + h * 3 + 0]))), g1_ = 1.0f / (1.0f + __expf(-bf2f(z[row * ZLD + E_GL + h * 3 + 1]))), g2_ = 1.0f / (1.0f + __expf(-bf2f(z[row * ZLD + E_GL + h * 3 + 2])));
        const float ref = g0_ * oc + g1_ * os + g2_ * ow;
        flag_bad(lds, differs(bf2f(mix[row * 1024 + 256 + h * 64 + d0]), ref), 14);
        if (rep == 0 && (wv & 15) == 0) { const int kv = (hsh >> 25) & 1, n = ((hsh >> 26) & 63) * 2 % 127, dd = (hsh >> 19) & 63; const float* pe = a.in[kv ? 18 : 15]; const float* w1 = a.in[kv ? 19 : 16]; const float* w2 = a.in[kv ? 20 : 17]; float acc = 0.f;
          for (int c = lane; c < 256; c += 64) { float hsum = 0.f;
              for (int kk = 0; kk < 2048; ++kk) { const int l = kk >> 6, d = kk & 63; hsum += (bf2f(zb[(size_t)(16 * n + l) * ZLD + (kv ? E_VC : E_KC) + g * 64 + d]) + pe[kk]) * w1[(size_t)kk * 256 + c]; }
              acc += gelu_tanh(hsum) * w2[c * 64 + dd]; }
          acc = wave_sum(acc);
          flag_bad(lds, differs(bf2f((kv ? Vc : Kc)[(size_t)n * 64 + dd]), acc), 15); }
    }
}
}
#endif

#define XB_TMO      128
#define XB_XCNT(j)  (256  + 64 * (j))
#define XB_XSUB(j)  (1280 + 64 * (j))
#define XB_XGEN(j)  (2304 + 64 * (j))
#define XB_TOP      3328
#define XB_TOPGEN   3392
#define XCD_BAR_WORDS 3456
#define XB_SPIN_CAP (1u << 18)
#define LAS __attribute__((address_space(3)))

__device__ __forceinline__ unsigned xb_ld(unsigned* p)              { return __hip_atomic_load(p, __ATOMIC_RELAXED, __HIP_MEMORY_SCOPE_AGENT); }
__device__ __forceinline__ unsigned xb_add(unsigned* p, unsigned v) { return __hip_atomic_fetch_add(p, v, __ATOMIC_RELAXED, __HIP_MEMORY_SCOPE_AGENT); }
__device__ __forceinline__ unsigned xb_xcc_id() { return (unsigned)__builtin_amdgcn_s_getreg((3 << 11) | 20) & 0xFu; }
#define XB_SPIN(cond, bar) do { unsigned _sp = 0; while (cond) { __builtin_amdgcn_s_sleep(1); \
    if ((++_sp & 255u) == 0u) { if (xb_ld(&(bar)[XB_TMO])) break; if (_sp > XB_SPIN_CAP) { atomicAdd(&(bar)[XB_TMO], 1u); break; } } } } while (0)

struct XcdBarrier {
    unsigned* bar; unsigned x;
    volatile LAS unsigned* st;
};

__device__ __forceinline__ XcdBarrier xcd_barrier_post(unsigned* bar, volatile LAS unsigned* st) {
    XcdBarrier b; b.bar = bar; b.x = xb_xcc_id(); b.st = st;
    if (threadIdx.x == 0) (void)xb_add(&bar[XB_XCNT(b.x)], 1u);
    return b;
}
__device__ __forceinline__ void xcd_barrier_complete(unsigned* bar, unsigned x, unsigned& nloc, unsigned& nx) {
    const unsigned G = gridDim.x * gridDim.y * gridDim.z;
    unsigned sum, cnt, mine, sp = 0u;
    for (;;) {
        sum = 0u; cnt = 0u; mine = 0u;
#pragma unroll
        for (unsigned j = 0; j < 16; ++j) { const unsigned c = xb_ld(&bar[XB_XCNT(j)]); sum += c; cnt += (c > 0u) ? 1u : 0u; mine = (j == x) ? c : mine; }
        if (sum == G) break;
        __builtin_amdgcn_s_sleep(1);
        if ((++sp & 255u) == 0u) { if (xb_ld(&bar[XB_TMO])) break; if (sp > XB_SPIN_CAP) { atomicAdd(&bar[XB_TMO], 1u); break; } }
    }
    nloc = mine > 0u ? mine : 1u; nx = cnt > 0u ? cnt : 1u;
}

__device__ __forceinline__ void xcd_barrier(const XcdBarrier& b) {
    asm volatile("s_waitcnt vmcnt(0)" ::: "memory");
    __syncthreads();
    if (threadIdx.x == 0) {
        unsigned* bar = b.bar;
        __builtin_amdgcn_s_waitcnt(0);
        unsigned nloc = b.st[0], nx = b.st[1];
        if (nloc == 0u) { xcd_barrier_complete(bar, b.x, nloc, nx); b.st[0] = nloc; b.st[1] = nx; }
        const unsigned old = xb_add(&bar[XB_XSUB(b.x)], 1u);
        const unsigned gen = old / nloc;
        if (old + 1u == (gen + 1u) * nloc) {
            __builtin_amdgcn_fence(__ATOMIC_RELEASE, "agent");
            asm volatile("s_waitcnt vmcnt(0)" ::: "memory");
            const unsigned og = xb_add(&bar[XB_TOP], 1u);
            const unsigned tg = og / nx;
            if (og + 1u == (tg + 1u) * nx) xb_add(&bar[XB_TOPGEN], 1u);
            else XB_SPIN(xb_ld(&bar[XB_TOPGEN]) == tg, bar);
            __builtin_amdgcn_fence(__ATOMIC_ACQUIRE, "agent");
            xb_add(&bar[XB_XGEN(b.x)], 1u);
            asm volatile("s_waitcnt vmcnt(0)" ::: "memory");
        } else {
            XB_SPIN(xb_ld(&bar[XB_XGEN(b.x)]) == gen, bar);
            __builtin_amdgcn_fence(__ATOMIC_ACQUIRE, "agent");
            asm volatile("s_waitcnt vmcnt(0)" ::: "memory");
        }
    }
    __syncthreads();
}
#define MK_ONE_LAUNCH 1
#define PROBE_MASK 0u
#ifndef MK_ONE_LAUNCH
#define MK_ONE_LAUNCH 1
#endif
constexpr int N_PHASES = 19;
__device__ __forceinline__ unsigned long long rt_now() { unsigned long long t; asm volatile("s_memrealtime %0\n\ts_waitcnt lgkmcnt(0)" : "=s"(t) :: "memory"); return t; }
__device__ __forceinline__ int bal16(int x) { const int k = x >> 4, c = x & 15; return (k << 4) + ((k & 1) ? 15 - c : c); }

__global__ void __launch_bounds__(512, 2) fwd(Args a) {
    extern __shared__ __attribute__((aligned(16))) unsigned char smem[];
    LAS char* lds = (LAS char*)smem;
    LAS unsigned* xbw = (LAS unsigned*)(lds + cfg::LDS_BYTES - 16);
    if (threadIdx.x < 4) xbw[threadIdx.x] = 0u;
    __syncthreads();
    XcdBarrier bar = xcd_barrier_post((unsigned*)(a.ws + wsm::CTL), (volatile LAS unsigned*)xbw);
    const int G = gridDim.x, wg = blockIdx.x;
    int pc = 0; bool on;
#ifndef PROBE_MASK
#define PROBE_MASK 0u
#endif
    unsigned long long ph_t0 = 0ull;
#ifdef PROBE_SUB
#define PROBE_SUBV 1
#else
#define PROBE_SUBV 0
#endif
#define PH_BEGIN() (ph_t0 = (PROBE_MASK ? rt_now() : 0ull), on = (pc >= a.ph_lo && pc < a.ph_hi))
#define PH_END() do { if (on && pc + 1 < a.ph_hi) xcd_barrier(bar); \
        if (PROBE_SUBV && ((PROBE_MASK >> pc) & 1u)) { __syncthreads(); const unsigned d_ = *(LAS unsigned*)(lds + cfg::LDS_BYTES - 8); const unsigned long long t1_ = rt_now(); while (rt_now() - t1_ < d_) __builtin_amdgcn_s_sleep(8); } \
        else if (PROBE_MASK && ((PROBE_MASK >> pc) & 1u)) { const unsigned long long t1_ = rt_now(), d_ = t1_ - ph_t0; while (rt_now() - t1_ < d_) __builtin_amdgcn_s_sleep(8); } \
        ++pc; } while (0)
    using namespace cfg;
    bf16_t* const xb = ph::wsb(a, wsm::XB); float* const ssq = ph::wsf(a, wsm::SSQ); bf16_t* const actz = ph::wsb(a, wsm::ACTZ); bf16_t* const mix = ph::wsb(a, wsm::MIX);

    if (PH_BEGIN()) ph::prologue(a, lds);
    PH_END();
#ifdef FIXED_DELAY_US
    { const unsigned long long t1_ = __builtin_amdgcn_s_memrealtime(); while (__builtin_amdgcn_s_memrealtime() - t1_ < (unsigned long long)FIXED_DELAY_US * 100ull) __builtin_amdgcn_s_sleep(8); }
#endif

    for (int L = 0; L < 2; ++L) {
        for (int hf = 0; hf < 2; ++hf) {
            if (hf == 1) {
                if (PH_BEGIN()) { pg8::Gemm g{xb, ph::wsb(a, wsm::WIN + L * wsm::WIN_1), M, ZLD, D}; pg8::StaticOrder so; so.init(M, ZLD, G, wg);
                    pg8::EpiZ E{actz, ZLD, ssq}; pg8::gemm_phase<pg8::EpiZ, pg8::StaticOrder, false>((PG8_LAS unsigned char*)smem, g, so, E, nullptr); }
                PH_END();
                if (L == 0) {
                    if (PH_BEGIN()) {
                        { SUBT_BEGIN(4); for (int u = wg; u < 768; u += G) ph::compress_unit(a, u, lds); SUBT_END(4, lds); }
                        { SUBT_BEGIN(5); for (int u = wg; u < 256; u += G) ph::gmlp_unit(a, u, lds); SUBT_END(5, lds); }
                        { SUBT_BEGIN(6); for (int u = wg; u < 1024; u += G) ph::rope_even_unit(a, u); SUBT_END(6, lds); }
                    }
                    PH_END();
                    if (PH_BEGIN()) {
                        for (int idx = wg; idx < 1536; idx += G) { const int b = idx & 15, rest = bal16(idx >> 4); ph::nsa_unit(a, b, rest % 3, rest / 3, lds); }
                    }
                    PH_END();
                } else {
                    if (PH_BEGIN()) { for (int u = wg; u < 1024; u += G) ph::rope_odd_unit(a, u); }
                    PH_END();
                    if (PH_BEGIN()) {
                        for (int idx = wg; idx < 2048; idx += G) ph::dsa_select_unit(a, idx & 15, bal16(idx >> 4), lds);
                        for (int u = wg; u < 128; u += G) ph::kmean_unit(a, u, lds);
                    }
                    PH_END();
                    if (PH_BEGIN()) {
                        for (int idx = wg; idx < 1024; idx += G) ph::dsa_attn_unit(a, idx & 15, bal16(idx >> 4), lds);
                        for (int idx = wg; idx < 1024; idx += G) { const int r = bal16(idx >> 4); ph::moba_unit(a, idx & 15, r & 7, r >> 3, lds); }
                    }
                    PH_END();
                }
                if (PH_BEGIN()) {
#ifdef PROBE_SUB
                    if (PROBE_SUB >= 9 && PROBE_SUB <= 19) { if (L == 0) chk::check_even(a, lds, PROBE_SUB); else chk::check_odd(a, lds, PROBE_SUB); __syncthreads(); }
#endif
                    pg8::Gemm g{mix, ph::wsb(a, wsm::WOUT + L * wsm::WOUT_1), M, D, D}; pg8::StaticOrder so; so.init(M, D, G, wg);
                    pg8::EpiResid E{xb, ssq, 1.0f}; pg8::gemm_phase<pg8::EpiResid, pg8::StaticOrder, false>((PG8_LAS unsigned char*)smem, g, so, E, nullptr); }
                PH_END();
            }
            const int f = 2 * L + hf;
            if (PH_BEGIN()) { pg8::Gemm g{xb, ph::wsb(a, wsm::WGU + f * wsm::WGU_1), M, NGU, D}; pg8::StaticOrder so; so.init(M, NGU, G, wg);
                pg8::EpiSwiGLU E{actz, ssq}; pg8::gemm_phase<pg8::EpiSwiGLU, pg8::StaticOrder, false>((PG8_LAS unsigned char*)smem, g, so, E, nullptr); }
            PH_END();
            if (PH_BEGIN()) { pg8::Gemm g{actz, ph::wsb(a, wsm::WD + f * wsm::WD_1), M, D, FF}; pg8::StaticOrder so; so.init(M, D, G, wg);
                pg8::EpiResid E{xb, ssq, 0.5f}; pg8::gemm_phase<pg8::EpiResid, pg8::StaticOrder, false>((PG8_LAS unsigned char*)smem, g, so, E, nullptr); }
            PH_END();
        }
    }
    if (PH_BEGIN()) ph::final_norm(a);
    PH_END();
#undef PH_BEGIN
#undef PH_END
}

extern "C" void kernel_launch(void* const* d_in, const int* in_sizes, int n_in, void* d_out, int out_size, void* d_ws, size_t ws_size, hipStream_t stream) {
    static int grid = 0;
    if (grid == 0) {
        if (n_in != 25 || out_size != cfg::M * cfg::D || ws_size < wsm::END) { fprintf(stderr, "kernel_launch: unexpected shapes (n_in %d, out %d, ws %zu < %zu)\n", n_in, out_size, ws_size, (size_t)wsm::END); grid = -1; return; }
        int dev = 0, cus = 0;
        if (hipGetDevice(&dev) != hipSuccess || hipDeviceGetAttribute(&cus, hipDeviceAttributeMultiprocessorCount, dev) != hipSuccess) { grid = -1; return; }
        if (hipFuncSetAttribute((const void*)fwd, hipFuncAttributeMaxDynamicSharedMemorySize, cfg::LDS_BYTES) != hipSuccess) { fprintf(stderr, "kernel_launch: hipFuncSetAttribute failed\n"); grid = -1; return; }
        int per_cu = 0; (void)hipOccupancyMaxActiveBlocksPerMultiprocessor(&per_cu, (const void*)fwd, 512, cfg::LDS_BYTES); (void)hipGetLastError();
        grid = cus;
    }
    if (grid < 0) return;
    (void)hipMemsetAsync((char*)d_ws + wsm::CTL, 0, wsm::CTL_BYTES, stream);
    Args a{};
    for (int i = 0; i < 25; ++i) a.in[i] = (const float*)d_in[i];
    a.out = (float*)d_out; a.ws = (unsigned char*)d_ws;
#if MK_ONE_LAUNCH
    a.ph_lo = 0; a.ph_hi = N_PHASES;
    hipLaunchKernelGGL(fwd, dim3(grid), dim3(512), cfg::LDS_BYTES, stream, a);
#else
    for (int p = 0; p < N_PHASES; ++p) { a.ph_lo = p; a.ph_hi = p + 1; hipLaunchKernelGGL(fwd, dim3(grid), dim3(512), cfg::LDS_BYTES, stream, a); }
#endif
}
```

```cpp
#include <hip/hip_runtime.h>
#include <stdint.h>
#include <stdio.h>

#define LAS __attribute__((address_space(3)))
typedef unsigned short bf16_t;
typedef short bf16x8 __attribute__((ext_vector_type(8)));
typedef short s16x4 __attribute__((ext_vector_type(4)));
typedef float f32x4 __attribute__((ext_vector_type(4)));
typedef float f32x16 __attribute__((ext_vector_type(16)));
typedef unsigned u32x4 __attribute__((ext_vector_type(4)));
typedef unsigned u32x2 __attribute__((ext_vector_type(2)));

namespace cfg {
constexpr int B = 16, S = 2048, D = 1024, M = B * S, FF = 2816, NGU = 2 * FF, ZLD = 2560, NTHR = 512;
constexpr int EV_NSRC = 2468, OD_NSRC = 2340;
constexpr int E_A = 0, E_Q = 512, E_KC = 1280, E_VC = 1472, E_KS = 1664, E_VS = 1856, E_KW = 2048, E_VW = 2240, E_GL = 2432;
constexpr int O_QC = 0, O_KC = 512, O_VC = 576, O_QI = 640, O_KI = 768, O_QD = 832, O_KD = 1344, O_VD = 1856, O_WI = 2368;
constexpr float EPS = 1e-6f;
constexpr float C2 = 0.125f * 1.4426950408889634f;
constexpr int LDS_BYTES = 144 * 1024;
}

namespace wsm {
constexpr size_t al(size_t x) { return (x + 255) & ~(size_t)255; }
constexpr size_t CTL = 0, CTL_BYTES = 16384;
constexpr size_t WGU = CTL + CTL_BYTES;                                  constexpr size_t WGU_1 = (size_t)cfg::NGU * cfg::D * 2;
constexpr size_t WD = WGU + 4 * WGU_1;                                   constexpr size_t WD_1 = (size_t)cfg::D * cfg::FF * 2;
constexpr size_t WIN = WD + 4 * WD_1;                                    constexpr size_t WIN_1 = (size_t)cfg::ZLD * cfg::D * 2;
constexpr size_t WOUT = WIN + 2 * WIN_1;                                 constexpr size_t WOUT_1 = (size_t)cfg::D * cfg::D * 2;
constexpr size_t CW1T = WOUT + 2 * WOUT_1;                               constexpr size_t CW1T_1 = (size_t)256 * 2048 * 2;
constexpr size_t CW2T = CW1T + 2 * CW1T_1;                               constexpr size_t CW2T_1 = (size_t)64 * 256 * 2;
constexpr size_t SGUW = CW2T + 2 * CW2T_1;
constexpr size_t C1P = SGUW + (size_t)4 * 128 * 128 * 2;
constexpr size_t ROPE16 = C1P + (size_t)2 * 32 * 256 * 4;
constexpr size_t ROPE8 = ROPE16 + (size_t)cfg::M * 16 * 4;
constexpr size_t SSQ = ROPE8 + (size_t)cfg::M * 8 * 4;
constexpr size_t XB = SSQ + (size_t)cfg::M * 16 * 4;
constexpr size_t ACTZ = XB + (size_t)cfg::M * cfg::D * 2;
constexpr size_t QROT = ACTZ + (size_t)cfg::M * cfg::FF * 2;
constexpr size_t MIX = QROT + (size_t)cfg::M * 768 * 2;
constexpr size_t KCMP = MIX + (size_t)cfg::M * 1024 * 2;
constexpr size_t VCMP = KCMP + (size_t)cfg::B * 3 * 128 * 64 * 2;
constexpr size_t DMASK = VCMP + (size_t)cfg::B * 3 * 128 * 64 * 2;
constexpr size_t KMEAN = DMASK + (size_t)cfg::M * 64 * 4;
constexpr size_t END = KMEAN + (size_t)cfg::B * 8 * 8 * 64 * 4;
static_assert(WGU % 256 == 0 && WD % 256 == 0 && ACTZ % 256 == 0 && QROT % 256 == 0 && KCMP % 256 == 0 && DMASK % 256 == 0, "alignment");
}

struct Args {
    const float* in[25];
    float* out;
    unsigned char* ws;
    int ph_lo, ph_hi;
};

__device__ __forceinline__ float bf2f(bf16_t b) { return __uint_as_float(((unsigned)b) << 16); }
__device__ __forceinline__ float bflo(unsigned w) { return __uint_as_float(w << 16); }
__device__ __forceinline__ float bfhi(unsigned w) { return __uint_as_float(w & 0xffff0000u); }
__device__ __forceinline__ bf16_t f2bf(float f) { unsigned u = __float_as_uint(f); u += 0x7FFFu + ((u >> 16) & 1u); return (bf16_t)(u >> 16); }
typedef __bf16 bf16v2_t __attribute__((ext_vector_type(2)));
typedef float f32v2_t __attribute__((ext_vector_type(2)));
__device__ __forceinline__ unsigned pk2(float lo, float hi) { const f32v2_t v = {lo, hi}; const bf16v2_t b = __builtin_convertvector(v, bf16v2_t); return __builtin_bit_cast(unsigned, b); }
__device__ __forceinline__ float fast_exp(float x) { return __builtin_amdgcn_exp2f(x * 1.4426950408889634f); }
__device__ __forceinline__ float sigmoidf_(float x) { return __builtin_amdgcn_rcpf(1.0f + fast_exp(-x)); }
__device__ __forceinline__ float gelu_tanh(float x) { const float y = 1.5957691216057308f * (x + 0.044715f * x * x * x); return x * sigmoidf_(y); }
__device__ __forceinline__ int crow(int r, int hi) { return (r & 3) + 8 * (r >> 2) + 4 * hi; }
__device__ __forceinline__ float swap32_max(float m) { auto rr = __builtin_amdgcn_permlane32_swap(__float_as_uint(m), __float_as_uint(m), false, false); return __builtin_fmaxf(__uint_as_float(rr[0]), __uint_as_float(rr[1])); }
__device__ __forceinline__ float swap32_sum(float m) { auto rr = __builtin_amdgcn_permlane32_swap(__float_as_uint(m), __float_as_uint(m), false, false); return __uint_as_float(rr[0]) + __uint_as_float(rr[1]); }
#define MFMA32(a, b, c) __builtin_amdgcn_mfma_f32_32x32x16_bf16(a, b, c, 0, 0, 0)
#define MFMA16(a, b, c) __builtin_amdgcn_mfma_f32_16x16x32_bf16(a, b, c, 0, 0, 0)
__device__ __forceinline__ s16x4 tr16(const char* p) { typedef short v4i16_t __attribute__((ext_vector_type(4))); return __builtin_bit_cast(s16x4, __builtin_amdgcn_ds_read_tr16_b64_v4i16((LAS v4i16_t*)p)); }
__device__ __forceinline__ float rstd_from_ssq(const float* ssq, int row) {
    const f32x4* p = (const f32x4*)(ssq + (size_t)row * 16); const f32x4 a = p[0], b = p[1], c = p[2], d = p[3];
    const float s = ((a[0] + a[1]) + (a[2] + a[3])) + ((b[0] + b[1]) + (b[2] + b[3])) + ((c[0] + c[1]) + (c[2] + c[3])) + ((d[0] + d[1]) + (d[2] + d[3]));
    return __builtin_amdgcn_rsqf(s * (1.0f / 1024.0f) + cfg::EPS);
}
namespace pg8 {
#define PG8_LAS __attribute__((address_space(3)))
typedef unsigned short bf16_t;
typedef short bf16x8 __attribute__((ext_vector_type(8)));
typedef float f32x4 __attribute__((ext_vector_type(4)));
typedef unsigned u32x4 __attribute__((ext_vector_type(4)));
constexpr int BM = 256, BK = 64, HALF = 128, HTB = HALF * BK * 2  , STAGE_BYTES = 8 * HTB, NXCD = 8, WGM = 8;

__host__ __device__ __forceinline__ int lds_byte(int r, int c) { const int st = (r >> 4) * 2 + (c >> 5), rr = r & 15, cc = c & 31, ob = rr * 64 + cc * 2; return st * 1024 + (ob ^ (((ob >> 9) & 1) << 5)); }
__host__ __device__ __forceinline__ void stage_rc(int b, int& R, int& C) { const int st = b / 1024, sb = b % 1024, swz = sb ^ (((sb >> 9) & 1) << 5); R = (st >> 1) * 16 + swz / 64; C = (st & 1) * 32 + (swz % 64) / 2; }
__host__ __device__ __forceinline__ int perm32(int rho) { const int n = rho >> 4, i = rho & 15; return 8 * (i >> 2) + 4 * n + (i & 3); }

struct Unit { int pm, pn; };
struct Gemm { const bf16_t* A; const bf16_t* Bt; int M, N, K; };

struct StaticOrder {
    int nM, nN, nwg, G, c;
    __host__ __device__ void init(int M, int N, int G_, int c_) { nM = M / BM; nN = N / BM; nwg = nM * nN; G = G_; c = c_; }
    __host__ __device__ bool next(int i, Unit& u) const {
        const long L = (long)i * G + c; if (L >= nwg) return false;
        int wgid = (int)L; { const int q = nwg / NXCD, r = nwg % NXCD, xcd = wgid % NXCD, off = wgid / NXCD; wgid = (xcd < r ? xcd * (q + 1) : r * (q + 1) + (xcd - r) * q) + off; }
        const int nig = WGM * nN, gid = wgid / nig, fm = gid * WGM, gsz = (nM - fm) < WGM ? (nM - fm) : WGM;
        u.pm = fm + ((wgid % nig) % gsz); u.pn = (wgid % nig) / gsz; return true;
    }
    __device__ __forceinline__ void a_ready(const Unit&) const {}
    __device__ __forceinline__ void done(const Unit&) const {}
};
__device__ __forceinline__ unsigned cvt_pk_bf16(float lo, float hi) { unsigned r; asm volatile("v_cvt_pk_bf16_f32 %0, %1, %2" : "=v"(r) : "v"(lo), "v"(hi)); return r; }
typedef float f32x2 __attribute__((ext_vector_type(2)));
struct EpiSwiGLU {
    static constexpr bool PERM = true, AFTER_DRAIN = false;
    bf16_t* act; const float* ssq;
    __device__ __forceinline__ void operator()(const f32x4 (&acc)[2][2][4][2], const Unit& u, int wr, int wc, int fr, int fq) const {
        const int row0 = u.pm * BM + wr * 64 + fr, col0 = u.pn * 128 + wc * 32 + 8 * fq;
#pragma unroll
        for (int ai = 0; ai < 2; ++ai)
#pragma unroll
            for (int m = 0; m < 4; ++m) {
                const int row = row0 + ai * HALF + m * 16; const float rs = rstd_from_ssq(ssq, row);
                float o[8];
#pragma unroll
                for (int n = 0; n < 2; ++n)
#pragma unroll
                    for (int j = 0; j < 4; ++j) { const float g = acc[ai][0][m][n][j] * rs, up = acc[ai][1][m][n][j] * rs; o[n * 4 + j] = g * sigmoidf_(g) * up; }
                u32x4 w; w.x = pk2(o[0], o[1]); w.y = pk2(o[2], o[3]); w.z = pk2(o[4], o[5]); w.w = pk2(o[6], o[7]);
                *(u32x4*)(act + (size_t)row * cfg::FF + col0) = w;
            }
    }
};
struct EpiZ {
    static constexpr bool PERM = true, AFTER_DRAIN = false;
    bf16_t* z; int ldc; const float* ssq;
    __device__ __forceinline__ void operator()(const f32x4 (&acc)[2][2][4][2], const Unit& u, int wr, int wc, int fr, int fq) const {
        const int row0 = u.pm * BM + wr * 64 + fr, col0 = u.pn * BM + wc * 32 + 8 * fq;
#pragma unroll
        for (int ai = 0; ai < 2; ++ai)
#pragma unroll
            for (int m = 0; m < 4; ++m) {
                const int row = row0 + ai * HALF + m * 16; const float rs = rstd_from_ssq(ssq, row);
#pragma unroll
                for (int bj = 0; bj < 2; ++bj) { const f32x4 v0 = acc[ai][bj][m][0] * rs, v1 = acc[ai][bj][m][1] * rs;
                    u32x4 w; w.x = pk2(v0[0], v0[1]); w.y = pk2(v0[2], v0[3]); w.z = pk2(v1[0], v1[1]); w.w = pk2(v1[2], v1[3]);
                    *(u32x4*)(z + (size_t)row * ldc + col0 + bj * HALF) = w; }
            }
    }
};
struct EpiResid {
    static constexpr bool PERM = true, AFTER_DRAIN = false;
    bf16_t* xb; float* ssq; float coef;
    __device__ __forceinline__ void operator()(const f32x4 (&acc)[2][2][4][2], const Unit& u, int wr, int wc, int fr, int fq) const {
        const int row0 = u.pm * BM + wr * 64 + fr, col0 = u.pn * BM + wc * 32 + 8 * fq;
#pragma unroll
        for (int ai = 0; ai < 2; ++ai)
#pragma unroll
            for (int m = 0; m < 4; ++m) {
                const int row = row0 + ai * HALF + m * 16; bf16_t* xp = xb + (size_t)row * cfg::D + col0; float s = 0.f;
                const u32x4 x0 = *(const u32x4*)xp, x1 = *(const u32x4*)(xp + HALF);
#pragma unroll
                for (int bj = 0; bj < 2; ++bj) { const u32x4 xi = bj ? x1 : x0; const f32x4 a0 = acc[ai][bj][m][0], a1 = acc[ai][bj][m][1]; float o[8];
                    o[0] = bflo(xi[0]) + coef * a0[0]; o[1] = bfhi(xi[0]) + coef * a0[1]; o[2] = bflo(xi[1]) + coef * a0[2]; o[3] = bfhi(xi[1]) + coef * a0[3];
                    o[4] = bflo(xi[2]) + coef * a1[0]; o[5] = bfhi(xi[2]) + coef * a1[1]; o[6] = bflo(xi[3]) + coef * a1[2]; o[7] = bfhi(xi[3]) + coef * a1[3];
#pragma unroll
                    for (int j = 0; j < 8; ++j) s += o[j] * o[j];
                    u32x4 w; w.x = pk2(o[0], o[1]); w.y = pk2(o[2], o[3]); w.z = pk2(o[4], o[5]); w.w = pk2(o[6], o[7]);
                    *(u32x4*)(xp + bj * HALF) = w; }
                s += __shfl_xor(s, 16); s += __shfl_xor(s, 32);
                if (fq == 0) ssq[(size_t)row * 16 + u.pn * 4 + wc] = s;
            }
    }
};
template <class Epi, class Sched, bool STAMP = false>
__device__ __forceinline__ void gemm_phase(PG8_LAS unsigned char* lds, const Gemm g, const Sched& S, const Epi& E, unsigned long long* stamps) {
    int tid_ = threadIdx.x; asm volatile("" : "+v"(tid_)); const int tid = tid_, wid = __builtin_amdgcn_readfirstlane(tid >> 6), lane = tid & 63, wr = wid >> 2, wc = wid & 3, fr = lane & 15, fq = lane >> 4;
    const int K = g.K, nt = K / BK;
    int ts_lo = 0, ts_hi = 0, nts = 0; const unsigned long long rt_entry = STAMP ? (unsigned long long)wall_clock64() : 0ull;
#define PG8_STAMP() do { if (STAMP && wid == 0 && nts < 64) { const unsigned long long _c = (unsigned long long)clock64(); \
        ts_lo = (lane == nts) ? (int)(unsigned)_c : ts_lo; ts_hi = (lane == nts) ? (int)(unsigned)(_c >> 32) : ts_hi; ++nts; } } while (0)
    PG8_STAMP();
    unsigned voffA[2], voffB[2];
#pragma unroll
    for (int i = 0; i < 2; ++i) { int R, C; stage_rc(tid * 16 + i * 8192, R, C); const int Rb = Epi::PERM ? ((R & ~31) + perm32(R & 31)) : R;
        voffA[i] = (unsigned)(R * K + C) * 2u; voffB[i] = (unsigned)(Rb * K + C) * 2u; }
    const size_t kstep = (size_t)(BK * 2);
    const size_t hstep = (size_t)HALF * K * 2;
    const size_t tstep = 2 * hstep;
    const unsigned ldsw = (unsigned)wid * 1024u;
    const int aoff = lds_byte(wr * 64 + fr, fq * 8), boff = lds_byte(wc * 32 + fr, fq * 8);
#define PG8_SA(b, h) (((b) * 2 + (h)) * HTB)
#define PG8_SB(b, h) ((4 + (b) * 2 + (h)) * HTB)
#define PG8_STAGE(bufoff, gbase, voff) do { _Pragma("unroll") for (int _i = 0; _i < 2; ++_i) \
        __builtin_amdgcn_global_load_lds((const unsigned*)((const char*)(gbase) + (voff)[_i]), (PG8_LAS unsigned*)(lds + (bufoff) + ldsw + _i * 8192), 16, 0, 0); } while (0)
#define PG8_LDA(dst, b, h) do { _Pragma("unroll") for (int m = 0; m < 4; ++m) _Pragma("unroll") for (int k = 0; k < 2; ++k) dst[m][k] = *(const PG8_LAS bf16x8*)(lds + PG8_SA(b, h) + aoff + m * 2048 + k * 1024); } while (0)
#define PG8_LDB(dst, b, h) do { _Pragma("unroll") for (int n = 0; n < 2; ++n) _Pragma("unroll") for (int k = 0; k < 2; ++k) dst[n][k] = *(const PG8_LAS bf16x8*)(lds + PG8_SB(b, h) + boff + n * 2048 + k * 1024); } while (0)
#define PG8_MMA(ai, bj, At, Bt) do { __builtin_amdgcn_s_setprio(1); _Pragma("unroll") for (int m = 0; m < 4; ++m) _Pragma("unroll") for (int n = 0; n < 2; ++n) _Pragma("unroll") for (int k = 0; k < 2; ++k) \
        acc[ai][bj][m][n] = __builtin_amdgcn_mfma_f32_16x16x32_bf16(Bt[n][k], At[m][k], acc[ai][bj][m][n], 0, 0, 0); __builtin_amdgcn_s_setprio(0); } while (0)
#define PG8_WAIT_V(n) asm volatile("s_waitcnt vmcnt(" #n ")" ::: "memory")
#define PG8_WAIT_L(n) asm volatile("s_waitcnt lgkmcnt(" #n ")" ::: "memory")
#define PG8_BAR __builtin_amdgcn_s_barrier()
#define PG8_SCHED __builtin_amdgcn_sched_barrier(0)
    Unit cur, nxt; int ui = 0;
    if (!S.next(0, cur)) return;
    f32x4 acc[2][2][4][2];
#pragma unroll
    for (int a = 0; a < 2; ++a)
#pragma unroll
        for (int b = 0; b < 2; ++b)
#pragma unroll
            for (int m = 0; m < 4; ++m)
#pragma unroll
                for (int n = 0; n < 2; ++n) acc[a][b][m][n] = (f32x4){0.f, 0.f, 0.f, 0.f};
    bf16x8 At[4][2], B0[2][2], B1[2][2];
    const char* cA = (const char*)g.A + (size_t)cur.pm * tstep; const char* cB = (const char*)g.Bt + (size_t)cur.pn * tstep;
    S.a_ready(cur);
    PG8_STAGE(PG8_SB(0, 0), cB, voffB); PG8_STAGE(PG8_SA(0, 0), cA, voffA); PG8_STAGE(PG8_SB(0, 1), cB + hstep, voffB); PG8_STAGE(PG8_SA(0, 1), cA + hstep, voffA);
    if (wr == 1) PG8_BAR;
    PG8_WAIT_V(4); PG8_BAR;
    PG8_STAGE(PG8_SB(1, 0), cB + kstep, voffB); PG8_STAGE(PG8_SA(1, 0), cA + kstep, voffA); PG8_STAGE(PG8_SB(1, 1), cB + hstep + kstep, voffB);
    PG8_WAIT_V(6); PG8_BAR;
    PG8_STAMP();
    for (;;) {
        const bool has_next = S.next(ui + 1, nxt);
        const char* nA = has_next ? (const char*)g.A + (size_t)nxt.pm * tstep : cA; const char* nB = has_next ? (const char*)g.Bt + (size_t)nxt.pn * tstep : cB;
        for (int t = 0; t < nt; t += 2) {
            const bool last = (t == nt - 2);
            const char* a1 = cA + (size_t)(t + 1) * kstep;
            const char* a2 = last ? nA : cA + (size_t)(t + 2) * kstep; const char* b2 = last ? nB : cB + (size_t)(t + 2) * kstep;
            const char* a3 = a2 + kstep; const char* b3 = b2 + kstep;
            if (last && has_next) S.a_ready(nxt);
            PG8_LDB(B0, 0, 0); PG8_SCHED; PG8_LDA(At, 0, 0); PG8_STAGE(PG8_SA(1, 1), a1 + hstep, voffA);
            PG8_WAIT_L(8); PG8_BAR; PG8_WAIT_L(0); PG8_MMA(0, 0, At, B0); PG8_BAR; PG8_SCHED;
            PG8_LDB(B1, 0, 1); PG8_STAGE(PG8_SB(0, 0), b2, voffB);
            PG8_BAR; PG8_WAIT_L(0); PG8_MMA(0, 1, At, B1); PG8_BAR;
            PG8_LDA(At, 0, 1); PG8_STAGE(PG8_SA(0, 0), a2, voffA);
            PG8_BAR; PG8_WAIT_L(0); PG8_MMA(1, 0, At, B0); PG8_BAR; PG8_SCHED;
            PG8_STAGE(PG8_SB(0, 1), b2 + hstep, voffB);
            PG8_WAIT_V(6); PG8_BAR; PG8_MMA(1, 1, At, B1); PG8_BAR;
            PG8_LDB(B0, 1, 0); PG8_SCHED; PG8_LDA(At, 1, 0); PG8_STAGE(PG8_SA(0, 1), a2 + hstep, voffA);
            PG8_WAIT_L(8); PG8_BAR; PG8_WAIT_L(0); PG8_MMA(0, 0, At, B0); PG8_BAR; PG8_SCHED;
            PG8_LDB(B1, 1, 1); PG8_STAGE(PG8_SB(1, 0), b3, voffB);
            PG8_BAR; PG8_WAIT_L(0); PG8_MMA(0, 1, At, B1); PG8_BAR;
            PG8_LDA(At, 1, 1); PG8_STAGE(PG8_SA(1, 0), a3, voffA);
            PG8_BAR; PG8_WAIT_L(0); PG8_MMA(1, 0, At, B0); PG8_BAR; PG8_SCHED;
            PG8_STAGE(PG8_SB(1, 1), b3 + hstep, voffB);
            PG8_WAIT_V(6); PG8_BAR; PG8_MMA(1, 1, At, B1); PG8_BAR;
        }
        PG8_STAMP();
        if constexpr (!Epi::AFTER_DRAIN) { E(acc, cur, wr, wc, fr, fq); S.done(cur); }
        PG8_STAMP();
        if (!has_next) break;
#pragma unroll
        for (int a = 0; a < 2; ++a)
#pragma unroll
            for (int b = 0; b < 2; ++b)
#pragma unroll
                for (int m = 0; m < 4; ++m)
#pragma unroll
                    for (int n = 0; n < 2; ++n) acc[a][b][m][n] = (f32x4){0.f, 0.f, 0.f, 0.f};
        cur = nxt; cA = nA; cB = nB; ++ui;
    }
    PG8_WAIT_V(0);
    if (wr == 0) PG8_BAR;
    PG8_BAR;
    if constexpr (Epi::AFTER_DRAIN) { E.fused(acc, cur, wr, wc, fr, fq, lds, wid, lane); S.done(cur); }
    PG8_STAMP();
    if (STAMP && wid == 0) { stamps[lane] = lane < nts ? (((unsigned long long)(unsigned)ts_hi << 32) | (unsigned)ts_lo) : 0ull;
        if (lane == 62) stamps[62] = rt_entry; if (lane == 63) stamps[63] = (unsigned long long)wall_clock64(); }
#undef PG8_STAMP
#undef PG8_SA
#undef PG8_SB
#undef PG8_STAGE
#undef PG8_LDA
#undef PG8_LDB
#undef PG8_MMA
#undef PG8_WAIT_V
#undef PG8_WAIT_L
#undef PG8_BAR
#undef PG8_SCHED
}
}
namespace ph {
using namespace cfg;
typedef LAS char* ldsp;
#ifdef PROBE_SUB
__device__ __forceinline__ unsigned long long rt_now_() { unsigned long long t; asm volatile("s_memrealtime %0\n\ts_waitcnt lgkmcnt(0)" : "=s"(t) :: "memory"); return t; }
#define SUBT_BEGIN(id) unsigned long long subt0_##id = (PROBE_SUB == (id)) ? ph::rt_now_() : 0ull
#define SUBT_END(id, lds_) do { if (PROBE_SUB == (id) && threadIdx.x == 0) *(LAS unsigned*)((lds_) + cfg::LDS_BYTES - 8) += (unsigned)(ph::rt_now_() - subt0_##id); } while (0)
#else
#define SUBT_BEGIN(id) do {} while (0)
#define SUBT_END(id, lds_) do {} while (0)
#endif
__device__ __forceinline__ int otid() { int t = threadIdx.x; asm volatile("" : "+v"(t)); return t; }

__device__ __forceinline__ bf16_t* wsb(const Args& a, size_t off) { return (bf16_t*)(a.ws + off); }
__device__ __forceinline__ float* wsf(const Args& a, size_t off) { return (float*)(a.ws + off); }

struct CvtJob { const float* src0; const float* src1; const float* gain; bf16_t* dst; int K, Nsrc, Ndst, mode; };
constexpr int T_GU = 16 * 22, T_DN = 44 * 4, T_WIN = 16 * 10, T_WOUT = 16 * 4, T_CW1 = 32 * 1, T_CW2 = 4 * 1;
constexpr int CVT_TILES = 4 * T_GU + 4 * T_DN + 2 * T_WIN + 2 * T_WOUT + 2 * T_CW1 + 2 * T_CW2;
__device__ __forceinline__ int odd_colmap(int n) { if (n < 800) return n; if (n < 832) return -1; if (n < 2368) return n - 28; if (n < 2372) return 800 + (n - 2368); return -1; }
__device__ __forceinline__ int cvt_job(const Args& a, int tile, CvtJob& J) {
    if (tile < 4 * T_GU) { const int f = tile / T_GU, L = f >> 1, w = f & 1; const size_t o = (size_t)L * D * FF;
        J = CvtJob{a.in[w ? 8 : 3] + o, a.in[w ? 9 : 4] + o, a.in[w ? 7 : 2] + L * D, wsb(a, wsm::WGU + f * wsm::WGU_1), D, FF, NGU, 1}; return tile - f * T_GU; }
    tile -= 4 * T_GU;
    if (tile < 4 * T_DN) { const int f = tile / T_DN, L = f >> 1, w = f & 1; const size_t o = (size_t)L * D * FF;
        J = CvtJob{a.in[w ? 10 : 5] + o, nullptr, nullptr, wsb(a, wsm::WD + f * wsm::WD_1), FF, D, D, 0}; return tile - f * T_DN; }
    tile -= 4 * T_DN;
    if (tile < T_WIN) { J = CvtJob{a.in[11], nullptr, a.in[6], wsb(a, wsm::WIN), D, EV_NSRC, ZLD, 0}; return tile; }
    tile -= T_WIN;
    if (tile < T_WIN) { J = CvtJob{a.in[22], nullptr, a.in[6] + D, wsb(a, wsm::WIN + wsm::WIN_1), D, OD_NSRC, ZLD, 2}; return tile; }
    tile -= T_WIN;
    if (tile < T_WOUT) { J = CvtJob{a.in[21], nullptr, nullptr, wsb(a, wsm::WOUT), D, D, D, 0}; return tile; }
    tile -= T_WOUT;
    if (tile < T_WOUT) { J = CvtJob{a.in[23], nullptr, nullptr, wsb(a, wsm::WOUT + wsm::WOUT_1), D, D, D, 0}; return tile; }
    tile -= T_WOUT;
    if (tile < 2 * T_CW1) { const int kv = tile / T_CW1; J = CvtJob{a.in[kv ? 19 : 16], nullptr, nullptr, wsb(a, wsm::CW1T + kv * wsm::CW1T_1), 2048, 256, 256, 0}; return tile - kv * T_CW1; }
    tile -= 2 * T_CW1;
    { const int kv = tile / T_CW2; J = CvtJob{a.in[kv ? 20 : 17], nullptr, nullptr, wsb(a, wsm::CW2T + kv * wsm::CW2T_1), 256, 64, 64, 0}; return tile - kv * T_CW2; }
}
__device__ __forceinline__ void cvt_tile(const CvtJob& J, int tile, ldsp lds) {
    const int tid = otid(), nb = J.Ndst >= 256 ? 4 : 1, ntn = J.Ndst / (64 * nb), tk = tile / ntn, tn = tile - tk * ntn, k0 = tk * 64, n0 = tn * 64 * nb;
    LAS bf16_t* T = (LAS bf16_t*)lds;
    { const int nn = tid & 63, kq = tid >> 6; float v[4][8];
#pragma unroll
      for (int q = 0; q < 4; ++q) { const int n = n0 + 64 * q + nn; const float* src = J.src0; int col;
          if (J.mode == 0) col = n < J.Nsrc ? n : -1;
          else if (J.mode == 1) { col = (n >> 8) * 128 + (n & 127); if ((n >> 7) & 1) src = J.src1; }
          else col = odd_colmap(n);
          if (q >= nb) col = -1;
#pragma unroll
          for (int i = 0; i < 8; ++i) v[q][i] = col >= 0 ? src[(size_t)(k0 + kq + 8 * i) * J.Nsrc + col] : 0.f; }
      float g[8];
#pragma unroll
      for (int i = 0; i < 8; ++i) g[i] = J.gain ? J.gain[k0 + kq + 8 * i] : 1.0f;
#pragma unroll
      for (int q = 0; q < 4; ++q)
#pragma unroll
          for (int i = 0; i < 8; ++i) T[(64 * q + nn) * 72 + kq + 8 * i] = f2bf(v[q][i] * g[i]); }
    __syncthreads();
#pragma unroll
    for (int q = 0; q < 4; ++q) if (q < nb) { const int nn = 64 * q + (tid >> 3), kc = tid & 7; const u32x4 w = *(const LAS u32x4*)(T + nn * 72 + kc * 8); *(u32x4*)(J.dst + (size_t)(n0 + nn) * J.K + k0 + kc * 8) = w; }
    __syncthreads();
}
__device__ __forceinline__ void sincos_pos(float ang, float& s, float& c) {
    const double k = __builtin_rint((double)ang * 0.15915494309189535); const float r = (float)__builtin_fma(-k, 6.283185307179586, (double)ang);
    s = __sinf(r); c = __cosf(r);
}
__device__ __forceinline__ void prologue(const Args& a, ldsp lds) {
    const int tid = otid(), wid = tid >> 6, lane = tid & 63, G = gridDim.x, wg = blockIdx.x;
    for (int t = wg; t < CVT_TILES; t += G) { CvtJob J; const int lt = cvt_job(a, t, J); cvt_tile(J, lt, lds); }
    { const float* x = a.in[0]; bf16_t* xb = wsb(a, wsm::XB); float* ssq = wsf(a, wsm::SSQ);
      for (int row = wg * 8 + wid; row < M; row += G * 16) {
          const int row2 = row + G * 8; const bool has2 = row2 < M; const int r2 = has2 ? row2 : row;
          f32x4 va[4], vb[4];
#pragma unroll
          for (int i = 0; i < 4; ++i) { va[i] = *(const f32x4*)(x + (size_t)row * D + i * 256 + lane * 4); vb[i] = *(const f32x4*)(x + (size_t)r2 * D + i * 256 + lane * 4); }
          float s0 = 0.f, s1 = 0.f;
#pragma unroll
          for (int i = 0; i < 4; ++i) { const int c = i * 256 + lane * 4; u32x2 w; w.x = pk2(va[i][0], va[i][1]); w.y = pk2(va[i][2], va[i][3]); *(u32x2*)(xb + (size_t)row * D + c) = w; s0 += (va[i][0] * va[i][0] + va[i][1] * va[i][1]) + (va[i][2] * va[i][2] + va[i][3] * va[i][3]);
              if (has2) { u32x2 w2; w2.x = pk2(vb[i][0], vb[i][1]); w2.y = pk2(vb[i][2], vb[i][3]); *(u32x2*)(xb + (size_t)r2 * D + c) = w2; } s1 += (vb[i][0] * vb[i][0] + vb[i][1] * vb[i][1]) + (vb[i][2] * vb[i][2] + vb[i][3] * vb[i][3]); }
#pragma unroll
          for (int o = 32; o >= 1; o >>= 1) { s0 += __shfl_xor(s0, o); s1 += __shfl_xor(s1, o); }
          if (lane < 16) { ssq[(size_t)row * 16 + lane] = lane == 0 ? s0 : 0.f; if (has2) ssq[(size_t)r2 * 16 + lane] = lane == 0 ? s1 : 0.f; }
      } }
    { const int* pos = (const int*)a.in[1]; float* r16 = wsf(a, wsm::ROPE16); float* r8 = wsf(a, wsm::ROPE8);
      const float inv16[8] = {1.0f, 0.1939227432012558f, 0.03760603070259094f, 0.007292664609849453f, 0.0014142135623842478f, 0.00027424818836152554f, 5.318296098266728e-05f, 1.0313386155758053e-05f};
      for (int i = wg * NTHR + tid; i < M; i += G * NTHR) { const float p = (float)pos[i];
#pragma unroll
          for (int j = 0; j < 8; ++j) { float s, c; sincos_pos(p * inv16[j], s, c); r16[(size_t)i * 16 + j] = c; r16[(size_t)i * 16 + 8 + j] = s;
              if ((j & 1) == 0) { r8[(size_t)i * 8 + (j >> 1)] = c; r8[(size_t)i * 8 + 4 + (j >> 1)] = s; } } } }
    { const float* w = a.in[13]; bf16_t* o = wsb(a, wsm::SGUW);
      for (int i = wg * NTHR + tid; i < 4 * 128 * 128; i += G * NTHR) { const int t = (i >> 7) & 127, s = i & 127; o[i] = f2bf(s <= t ? w[i] : 0.f); } }
    { LAS float* red = (LAS float*)lds;
      for (int u = wg; u < 64; u += G) { const int kv = u >> 5, p = u & 31, c = tid & 255, hf = tid >> 8; const float* pe = a.in[kv ? 18 : 15]; const float* w1 = a.in[kv ? 19 : 16];
          float s = 0.f; for (int i = 0; i < 32; ++i) { const int kk = p * 64 + hf * 32 + i; s += pe[kk] * w1[(size_t)kk * 256 + c]; }
          if (hf) red[c] = s; __syncthreads(); if (!hf) wsf(a, wsm::C1P)[(kv * 32 + p) * 256 + c] = s + red[c]; __syncthreads(); } }
}

__device__ __forceinline__ void final_norm(const Args& a) {
    const int tid = otid(), wid = tid >> 6, lane = tid & 63, G = gridDim.x, wg = blockIdx.x; const float* ssq = wsf(a, wsm::SSQ); const float* g = a.in[24]; const bf16_t* xb = wsb(a, wsm::XB);
    f32x4 gv[4];
#pragma unroll
    for (int i = 0; i < 4; ++i) gv[i] = *(const f32x4*)(g + lane * 16 + 4 * i);
    for (int row = wg * 8 + wid; row < M; row += G * 16) {
        const int row2 = row + G * 8; const bool has2 = row2 < M; const int r2 = has2 ? row2 : row;
        const float rs0 = rstd_from_ssq(ssq, row), rs1 = rstd_from_ssq(ssq, r2);
        const u32x4 a0 = *(const u32x4*)(xb + (size_t)row * D + lane * 16), a1 = *(const u32x4*)(xb + (size_t)row * D + lane * 16 + 8);
        const u32x4 b0 = *(const u32x4*)(xb + (size_t)r2 * D + lane * 16), b1 = *(const u32x4*)(xb + (size_t)r2 * D + lane * 16 + 8);
        float* o0 = a.out + (size_t)row * D + lane * 16; float* o1 = a.out + (size_t)r2 * D + lane * 16;
#pragma unroll
        for (int i = 0; i < 4; ++i) { const u32x4& w = i < 2 ? a0 : a1; const int k = (i & 1) * 2; const f32x4 v = {bflo(w[k]), bfhi(w[k]), bflo(w[k + 1]), bfhi(w[k + 1])}; *(f32x4*)(o0 + 4 * i) = v * rs0 * gv[i]; }
        if (has2) {
#pragma unroll
            for (int i = 0; i < 4; ++i) { const u32x4& w = i < 2 ? b0 : b1; const int k = (i & 1) * 2; const f32x4 v = {bflo(w[k]), bfhi(w[k]), bflo(w[k + 1]), bfhi(w[k + 1])}; *(f32x4*)(o1 + 4 * i) = v * rs1 * gv[i]; } }
    }
}

__device__ __forceinline__ void rot16(const bf16_t* src, bf16_t* dst, const float* cs) {
    const u32x4 a = *(const u32x4*)src, b = *(const u32x4*)(src + 8); const f32x4 c0 = *(const f32x4*)cs, c1 = *(const f32x4*)(cs + 4), s0 = *(const f32x4*)(cs + 8), s1 = *(const f32x4*)(cs + 12);
    float x1[8], x2[8], c[8], s[8];
#pragma unroll
    for (int i = 0; i < 4; ++i) { x1[2 * i] = bflo(a[i]); x1[2 * i + 1] = bfhi(a[i]); x2[2 * i] = bflo(b[i]); x2[2 * i + 1] = bfhi(b[i]); c[i] = c0[i]; c[4 + i] = c1[i]; s[i] = s0[i]; s[4 + i] = s1[i]; }
    u32x4 oa, ob;
#pragma unroll
    for (int i = 0; i < 4; ++i) { oa[i] = pk2(x1[2 * i] * c[2 * i] - x2[2 * i] * s[2 * i], x1[2 * i + 1] * c[2 * i + 1] - x2[2 * i + 1] * s[2 * i + 1]);
                                  ob[i] = pk2(x2[2 * i] * c[2 * i] + x1[2 * i] * s[2 * i], x2[2 * i + 1] * c[2 * i + 1] + x1[2 * i + 1] * s[2 * i + 1]); }
    *(u32x4*)dst = oa; *(u32x4*)(dst + 8) = ob;
}
__device__ __forceinline__ void rot8(bf16_t* p, const float* cs) {
    const u32x4 a = *(const u32x4*)p; const f32x4 c = *(const f32x4*)cs, s = *(const f32x4*)(cs + 4);
    const float x1[4] = {bflo(a[0]), bfhi(a[0]), bflo(a[1]), bfhi(a[1])}, x2[4] = {bflo(a[2]), bfhi(a[2]), bflo(a[3]), bfhi(a[3])};
    u32x4 o; o[0] = pk2(x1[0] * c[0] - x2[0] * s[0], x1[1] * c[1] - x2[1] * s[1]); o[1] = pk2(x1[2] * c[2] - x2[2] * s[2], x1[3] * c[3] - x2[3] * s[3]);
    o[2] = pk2(x2[0] * c[0] + x1[0] * s[0], x2[1] * c[1] + x1[1] * s[1]); o[3] = pk2(x2[2] * c[2] + x1[2] * s[2], x2[3] * c[3] + x1[3] * s[3]);
    *(u32x4*)p = o;
}
__device__ __forceinline__ void rope_even_unit(const Args& a, int u) {
    bf16_t* z = wsb(a, wsm::ACTZ); bf16_t* qr = wsb(a, wsm::QROT); const float* r16 = wsf(a, wsm::ROPE16);
    for (int it = otid(); it < 32 * 18; it += NTHR) { const int tok = u * 32 + it / 18, sl = it % 18; const float* cs = r16 + (size_t)tok * 16;
        if (sl < 12) { const bf16_t* src = z + (size_t)tok * ZLD + E_Q + sl * 64; bf16_t* dst = qr + (size_t)tok * 768 + sl * 64; rot16(src, dst, cs);
#pragma unroll
            for (int i = 2; i < 8; ++i) *(u32x4*)(dst + 8 * i) = *(const u32x4*)(src + 8 * i); }
        else { bf16_t* p = z + (size_t)tok * ZLD + (sl < 15 ? E_KS + (sl - 12) * 64 : E_KW + (sl - 15) * 64); rot16(p, p, cs); } }
}
__device__ __forceinline__ void rope_odd_unit(const Args& a, int u) {
    bf16_t* z = wsb(a, wsm::ACTZ); const float* r16 = wsf(a, wsm::ROPE16); const float* r8 = wsf(a, wsm::ROPE8);
    for (int it = otid(); it < 32 * 30; it += NTHR) { const int tok = u * 32 + it / 30, sl = it % 30; bf16_t* zr = z + (size_t)tok * ZLD;
        if (sl < 25) { const int col = sl < 8 ? O_QC + sl * 64 : (sl == 8 ? O_KC : (sl < 17 ? O_QD + (sl - 9) * 64 : O_KD + (sl - 17) * 64)); rot16(zr + col, zr + col, r16 + (size_t)tok * 16); }
        else { const int col = sl < 29 ? O_QI + (sl - 25) * 32 : O_KI; rot8(zr + col, r8 + (size_t)tok * 8);
#ifdef PROBE_SUB
            if (PROBE_SUB == 25 && sl == 29) { const u32x4 w = *(const u32x4*)(zr + col); ((unsigned*)(a.ws + wsm::END))[tok] = w[0] ^ w[1] ^ w[2] ^ w[3]; }
#endif
        } }
}

__device__ __forceinline__ void gmlp_unit(const Args& a, int u, ldsp lds) {
    const int tid = otid(), wid = __builtin_amdgcn_readfirstlane(tid >> 6), lane = tid & 63, fr = lane & 15, fq = lane >> 4;
    const bf16_t* z = wsb(a, wsm::ACTZ); bf16_t* mix = wsb(a, wsm::MIX); const int row0 = u * 128;
    constexpr int PIT = 528;
    ldsp U = lds, V = lds + 128 * PIT;
    { const int s = tid >> 2, qd = tid & 3; const bf16_t* zr = z + (size_t)(row0 + s) * ZLD + qd * 64; const float* gn = a.in[12] + qd * 64;
      float vv[64]; float ss = 0.f;
#pragma unroll
      for (int i = 0; i < 8; ++i) { const u32x4 wu = *(const u32x4*)(zr + 8 * i), wv = *(const u32x4*)(zr + 256 + 8 * i); u32x4 ou;
#pragma unroll
          for (int j = 0; j < 4; ++j) { ou[j] = pk2(gelu_tanh(bflo(wu[j])), gelu_tanh(bfhi(wu[j]))); const float v0 = gelu_tanh(bflo(wv[j])), v1 = gelu_tanh(bfhi(wv[j])); vv[8 * i + 2 * j] = v0; vv[8 * i + 2 * j + 1] = v1; ss += v0 * v0 + v1 * v1; }
          *(LAS u32x4*)(U + s * PIT + qd * 128 + i * 16) = ou; }
      ss += __shfl_xor(ss, 1); ss += __shfl_xor(ss, 2);
      const float rs = __builtin_amdgcn_rsqf(ss * (1.0f / 256.0f) + EPS);
#pragma unroll
      for (int i = 0; i < 8; ++i) { const f32x4 g0 = *(const f32x4*)(gn + 8 * i), g1 = *(const f32x4*)(gn + 8 * i + 4); u32x4 ov;
          ov[0] = pk2(vv[8 * i] * rs * g0[0], vv[8 * i + 1] * rs * g0[1]); ov[1] = pk2(vv[8 * i + 2] * rs * g0[2], vv[8 * i + 3] * rs * g0[3]);
          ov[2] = pk2(vv[8 * i + 4] * rs * g1[0], vv[8 * i + 5] * rs * g1[1]); ov[3] = pk2(vv[8 * i + 6] * rs * g1[2], vv[8 * i + 7] * rs * g1[3]);
          *(LAS u32x4*)(V + s * PIT + qd * 128 + i * 16) = ov; } }
    __syncthreads();
    { const bf16_t* W = wsb(a, wsm::SGUW); const float* bias = a.in[14]; const int nks = (16 * wid + 15) / 32 + 1;
#pragma unroll 1
      for (int g = 0; g < 4; ++g) {
          bf16x8 af[4];
#pragma unroll
          for (int ks = 0; ks < 4; ++ks) af[ks] = *(const bf16x8*)(W + ((size_t)g * 128 + 16 * wid + fr) * 128 + 32 * ks + 8 * fq);
#pragma unroll
          for (int dt = 0; dt < 4; ++dt) { f32x4 acc = {0.f, 0.f, 0.f, 0.f}; const int d = g * 64 + dt * 16;
#pragma unroll
              for (int ks = 0; ks < 4; ++ks) if (ks < nks) { ldsp vp = V + (32 * ks + 8 * fq + (fr >> 2)) * PIT + (d + 4 * (fr & 3)) * 2; const s16x4 lo = tr16((const char*)vp), hi = tr16((const char*)(vp + 4 * PIT));
                  const bf16x8 bfr = {lo[0], lo[1], lo[2], lo[3], hi[0], hi[1], hi[2], hi[3]}; acc = MFMA16(af[ks], bfr, acc); }
#pragma unroll
              for (int i = 0; i < 4; ++i) { const int t = 16 * wid + 4 * fq + i; const float uu = bf2f(*(const LAS bf16_t*)(U + t * PIT + (d + fr) * 2)); mix[(size_t)(row0 + t) * 1024 + d + fr] = f2bf(uu * (acc[i] + bias[g * 128 + t])); } }
      } }
    __syncthreads();
}

__device__ __forceinline__ void compress_unit(const Args& a, int u, ldsp lds) {
    const int tid = otid(), wid = __builtin_amdgcn_readfirstlane(tid >> 6), lane = tid & 63, fr = lane & 15, fq = lane >> 4;
    const int nt = u & 7, g = (u >> 3) % 3, b = ((u >> 3) / 3) & 15, kv = (u >> 3) / 48;
    const bf16_t* z = wsb(a, wsm::ACTZ); const bf16_t* w1t = wsb(a, wsm::CW1T + kv * wsm::CW1T_1); const bf16_t* w2t = wsb(a, wsm::CW2T + kv * wsm::CW2T_1);
    LAS float* c1 = (LAS float*)lds; ldsp Hs = lds + 1024; constexpr int PIT = 528;
    if (tid < 256) { const float* p = wsf(a, wsm::C1P) + (size_t)kv * 32 * 256 + tid; float s = 0.f;
#pragma unroll 8
        for (int i = 0; i < 32; ++i) s += p[i * 256]; c1[tid] = s; }
    __syncthreads();
    int n = nt * 16 + fr; if (n > 126) n = 126;
    const bf16_t* ap = z + ((size_t)b * S + 16 * n) * ZLD + (kv ? E_VC : E_KC) + g * 64 + 8 * fq;
    const bf16_t* bp0 = w1t + (size_t)(32 * wid + fr) * 2048 + 8 * fq; const bf16_t* bp1 = bp0 + 16 * 2048;
    f32x4 acc0 = {0.f, 0.f, 0.f, 0.f}, acc1 = {0.f, 0.f, 0.f, 0.f};
#pragma unroll 1
    for (int c8 = 0; c8 < 8; ++c8) {
        bf16x8 af[8], b0[8], b1[8];
#pragma unroll
        for (int j = 0; j < 8; ++j) { const int st = c8 * 8 + j, l = st >> 1, d0 = (st & 1) * 32;
            af[j] = *(const bf16x8*)(ap + (size_t)l * ZLD + d0); b0[j] = *(const bf16x8*)(bp0 + st * 32); b1[j] = *(const bf16x8*)(bp1 + st * 32); }
        __builtin_amdgcn_sched_barrier(0);
#pragma unroll
        for (int j = 0; j < 8; ++j) { acc0 = MFMA16(af[j], b0[j], acc0); acc1 = MFMA16(af[j], b1[j], acc1); }
        __builtin_amdgcn_sched_barrier(0);
    }
#pragma unroll
    for (int i = 0; i < 4; ++i) { const int r = 4 * fq + i, c0 = 32 * wid + fr;
        *(LAS bf16_t*)(Hs + r * PIT + c0 * 2) = f2bf(gelu_tanh(acc0[i] + c1[c0])); *(LAS bf16_t*)(Hs + r * PIT + (c0 + 16) * 2) = f2bf(gelu_tanh(acc1[i] + c1[c0 + 16])); }
    __syncthreads();
    if (wid < 4) { f32x4 acc = {0.f, 0.f, 0.f, 0.f};
#pragma unroll
        for (int ks = 0; ks < 8; ++ks) { const bf16x8 af = *(const LAS bf16x8*)(Hs + fr * PIT + (32 * ks + 8 * fq) * 2), bfr = *(const bf16x8*)(w2t + (size_t)(16 * wid + fr) * 256 + 32 * ks + 8 * fq); acc = MFMA16(af, bfr, acc); }
        bf16_t* o = wsb(a, kv ? wsm::VCMP : wsm::KCMP) + ((size_t)(b * 3 + g) * 128) * 64;
#pragma unroll
        for (int i = 0; i < 4; ++i) { const int nn = nt * 16 + 4 * fq + i; o[(size_t)nn * 64 + 16 * wid + fr] = nn > 126 ? (bf16_t)0 : f2bf(acc[i]); } }
    __syncthreads();
}

struct AttnAcc { f32x16 o0, o1, negm; float l; bool started; float m; };
constexpr float ATT_THR = 8.0f;
#ifndef ATT_OLD
#define ATT_OLD 1
#endif
__device__ __forceinline__ void acc_init(AttnAcc& A) {
#pragma unroll
    for (int r = 0; r < 16; ++r) { A.o0[r] = 0.f; A.o1[r] = 0.f; A.negm[r] = 0.f; }
    A.l = 0.f; A.started = false; A.m = -1e30f; }
__device__ __forceinline__ bf16x8 scale_q(bf16x8 q) { u32x4 w = __builtin_bit_cast(u32x4, q);
#pragma unroll
    for (int i = 0; i < 4; ++i) w[i] = pk2(bflo(w[i]) * C2, bfhi(w[i]) * C2);
    return __builtin_bit_cast(bf16x8, w); }
__device__ __forceinline__ void stage_kv(const bf16_t* Kt, int ldk, const bf16_t* Vt, int ldv, ldsp slot, int wid, int lane) {
    const bf16_t* ks = Kt + (size_t)lane * ldk + wid * 8;
    const bf16_t* vs = Vt + (size_t)(16 * (wid & 3) + (lane >> 2)) * ldv + (wid >> 2) * 32 + (lane & 3) * 8;
    __builtin_amdgcn_global_load_lds((const unsigned*)ks, (LAS unsigned*)(slot + wid * 1024), 16, 0, 0);
    __builtin_amdgcn_global_load_lds((const unsigned*)vs, (LAS unsigned*)(slot + 8192 + wid * 1024), 16, 0, 0);
}
__device__ __forceinline__ void load_kfrags(bf16x8 (&kf)[8], ldsp slot, int lane) {
    ldsp kp = slot + (lane >> 5) * 1024 + (lane & 31) * 16;
#pragma unroll
    for (int d0 = 0; d0 < 4; ++d0) { kf[2 * d0] = *(const LAS bf16x8*)(kp + d0 * 2048); kf[2 * d0 + 1] = *(const LAS bf16x8*)(kp + d0 * 2048 + 512); }
}
__device__ __forceinline__ void pv_tile(f32x16& o0, f32x16& o1, const f32x16& p0, const f32x16& p1, ldsp slot, int lane) {
    const int hi = lane >> 5;
    u32x4 pw[4];
#pragma unroll
    for (int i = 0; i < 4; ++i) { pw[0][i] = pk2(p0[2 * i], p0[2 * i + 1]); pw[1][i] = pk2(p0[8 + 2 * i], p0[9 + 2 * i]); pw[2][i] = pk2(p1[2 * i], p1[2 * i + 1]); pw[3][i] = pk2(p1[8 + 2 * i], p1[9 + 2 * i]); }
    ldsp vp = slot + 8192 + ((lane >> 4) & 1) * 32 + (lane & 3) * 8 + (4 * hi + ((lane & 15) >> 2)) * 64;
#pragma unroll
    for (int s = 0; s < 4; ++s) { const bf16x8 pf = __builtin_bit_cast(bf16x8, pw[s]);
        { const s16x4 lo = tr16((const char*)(vp + s * 1024)), h4 = tr16((const char*)(vp + s * 1024 + 512)); const bf16x8 vf = {lo[0], lo[1], lo[2], lo[3], h4[0], h4[1], h4[2], h4[3]}; o0 = MFMA32(vf, pf, o0); }
        { const s16x4 lo = tr16((const char*)(vp + 4096 + s * 1024)), h4 = tr16((const char*)(vp + 4096 + s * 1024 + 512)); const bf16x8 vf = {lo[0], lo[1], lo[2], lo[3], h4[0], h4[1], h4[2], h4[3]}; o1 = MFMA32(vf, pf, o1); } }
}
#define MX3(a, b, c) __builtin_fmaxf(__builtin_fmaxf((a), (b)), (c))
template <class MF> __device__ __forceinline__ void attn_tile(AttnAcc& A, const bf16x8 (&qr)[4], ldsp slot, int t, const MF& mf, bool masked, int lane) {
    const int hi = lane >> 5;
    bf16x8 kf[8]; load_kfrags(kf, slot, lane);
    f32x16 c0 = MFMA32(kf[0], qr[0], A.negm), c1 = MFMA32(kf[1], qr[0], A.negm);
#pragma unroll
    for (int d0 = 1; d0 < 4; ++d0) { c0 = MFMA32(kf[2 * d0], qr[d0], c0); c1 = MFMA32(kf[2 * d0 + 1], qr[d0], c1); }
    if (masked) {
#pragma unroll
        for (int r = 0; r < 16; ++r) { const int k0 = crow(r, hi); c0[r] = mf.ok(t, k0) ? c0[r] : -INFINITY; c1[r] = mf.ok(t, k0 + 32) ? c1[r] : -INFINITY; }
    }
    float ra = MX3(c0[0], c0[1], c1[0]), rb = MX3(c0[2], c0[3], c1[1]); ra = MX3(ra, c1[2], c1[3]);
#pragma unroll
    for (int r = 4; r < 16; r += 4) { ra = MX3(ra, c0[r], c0[r + 1]); rb = MX3(rb, c0[r + 2], c0[r + 3]); ra = MX3(ra, c1[r], c1[r + 1]); rb = MX3(rb, c1[r + 2], c1[r + 3]); }
    const float rm = swap32_max(__builtin_fmaxf(ra, rb));
#if ATT_OLD
    { const float mn = __builtin_fmaxf(A.m, rm), alpha = __builtin_amdgcn_exp2f(A.m - mn); A.m = mn; float sum = 0.f;
#pragma unroll
      for (int r = 0; r < 16; ++r) { c0[r] = __builtin_amdgcn_exp2f(c0[r] - mn); c1[r] = __builtin_amdgcn_exp2f(c1[r] - mn); sum += c0[r] + c1[r]; }
      A.l = A.l * alpha + sum;
#pragma unroll
      for (int r = 0; r < 16; ++r) { A.o0[r] *= alpha; A.o1[r] *= alpha; } }
#else
    const bool fin = rm > -INFINITY;
    float delta = 0.f;
    if (!A.started) { if (fin) delta = rm; } else if (rm > ATT_THR) delta = rm;
    if (__any(delta != 0.f)) {
        const float alpha = A.started ? __builtin_amdgcn_exp2f(-delta) : 1.0f;
#pragma unroll
        for (int r = 0; r < 16; ++r) { c0[r] -= delta; c1[r] -= delta; A.o0[r] *= alpha; A.o1[r] *= alpha; A.negm[r] -= delta; }
        A.l *= alpha;
    }
    A.started = A.started || fin;
    float s0 = 0.f, s1 = 0.f;
#pragma unroll
    for (int r = 0; r < 16; ++r) { c0[r] = __builtin_amdgcn_exp2f(c0[r]); c1[r] = __builtin_amdgcn_exp2f(c1[r]); s0 += c0[r]; s1 += c1[r]; }
    A.l += s0 + s1;
#endif
    pv_tile(A.o0, A.o1, c0, c1, slot, lane);
}
template <class MF> __device__ __forceinline__ void attn_run(AttnAcc& A, const bf16x8 (&qr)[4], const bf16_t* K, int ldk, const bf16_t* V, int ldv, int tb, int te, MF& mf, ldsp kv, int wid, int lane) {
    if (tb >= te) return;
    stage_kv(K + (size_t)tb * 64 * ldk, ldk, V + (size_t)tb * 64 * ldv, ldv, kv, wid, lane);
    for (int t = tb; t < te; ++t) {
        ldsp cur = kv + ((t - tb) & 1) * 16384, nxt = kv + (((t - tb) & 1) ^ 1) * 16384;
        asm volatile("s_waitcnt vmcnt(0)" ::: "memory"); __syncthreads();
        if (t + 1 < te) stage_kv(K + (size_t)(t + 1) * 64 * ldk, ldk, V + (size_t)(t + 1) * 64 * ldv, ldv, nxt, wid, lane);
        const int kd = mf.prep(t);
        if (kd) attn_tile(A, qr, cur, t, mf, kd == 2, lane);
    }
    __syncthreads();
}
__device__ __forceinline__ float acc_inv(const AttnAcc& A) { const float l = swap32_sum(A.l); return l > 0.f ? __builtin_amdgcn_rcpf(l) : 0.f; }
__device__ __forceinline__ void store_rows(bf16_t* dst  , const f32x16& o0, const f32x16& o1, float sc, int hi) {
#pragma unroll
    for (int gq = 0; gq < 4; ++gq) { u32x2 w0, w1; w0.x = pk2(o0[4 * gq] * sc, o0[4 * gq + 1] * sc); w0.y = pk2(o0[4 * gq + 2] * sc, o0[4 * gq + 3] * sc); w1.x = pk2(o1[4 * gq] * sc, o1[4 * gq + 1] * sc); w1.y = pk2(o1[4 * gq + 2] * sc, o1[4 * gq + 3] * sc);
        *(u32x2*)(dst + 8 * gq + 4 * hi) = w0; *(u32x2*)(dst + 32 + 8 * gq + 4 * hi) = w1; }
}

struct SlcMF { unsigned sel; int jq, trel;
    __device__ __forceinline__ int prep(int t) const { const bool bit = (sel >> t) & 1u; if (!__any(bit)) return 0; return (t < jq && __all(bit)) ? 1 : 2; }
    __device__ __forceinline__ bool ok(int t, int kr) const { return ((sel >> t) & 1u) && (t < jq || kr <= trel); } };
struct WinMF { int jq, trel;
    __device__ __forceinline__ int prep(int t) const { return (t == jq || t == jq - 8) ? 2 : 1; }
    __device__ __forceinline__ bool ok(int t, int kr) const { return t == jq ? kr <= trel : (t == jq - 8 ? kr > trel : true); } };
__device__ __forceinline__ void nsa_unit(const Args& a, int b, int g, int jq, ldsp lds) {
    const int tid = otid(), wid = __builtin_amdgcn_readfirstlane(tid >> 6), lane = tid & 63, r32 = lane & 31, hi = lane >> 5;
    const int ql = r32 >> 2, hr = r32 & 3, trel = wid * 8 + ql, tok = jq * 64 + trel, h = 4 * g + hr; const size_t row = (size_t)b * S + tok;
    const bf16_t* z = wsb(a, wsm::ACTZ); const bf16_t* qrot = wsb(a, wsm::QROT); const bf16_t* zb = z + (size_t)b * S * ZLD;
    ldsp kv = lds; LAS float* psum = (LAS float*)(lds + 32768) + wid * 1024; LAS float* impw = (LAS float*)(lds + 65536) + wid * 256;
    float gate[3];
#pragma unroll
    for (int i = 0; i < 3; ++i) gate[i] = sigmoidf_(bf2f(z[row * ZLD + E_GL + h * 3 + i]));
    f32x16 out0, out1; unsigned sel;
    {
        const bf16_t* Kc = wsb(a, wsm::KCMP) + (size_t)(b * 3 + g) * 128 * 64; const bf16_t* Vc = wsb(a, wsm::VCMP) + (size_t)(b * 3 + g) * 128 * 64;
        stage_kv(Kc, 64, Vc, 64, kv, wid, lane); stage_kv(Kc + 64 * 64, 64, Vc + 64 * 64, 64, kv + 16384, wid, lane);
        asm volatile("s_waitcnt vmcnt(0)" ::: "memory"); __syncthreads();
        f32x16 c[4];
        bf16x8 qn[4];
#pragma unroll
        for (int d0 = 0; d0 < 4; ++d0) qn[d0] = scale_q(*(const bf16x8*)(z + row * ZLD + E_Q + h * 64 + 16 * d0 + 8 * hi));
#pragma unroll
        for (int tt = 0; tt < 2; ++tt) { bf16x8 kf[8]; load_kfrags(kf, kv + tt * 16384, lane);
#pragma unroll
            for (int r = 0; r < 16; ++r) { c[2 * tt][r] = 0.f; c[2 * tt + 1][r] = 0.f; }
#pragma unroll
            for (int d0 = 0; d0 < 4; ++d0) { c[2 * tt] = MFMA32(kf[2 * d0], qn[d0], c[2 * tt]); c[2 * tt + 1] = MFMA32(kf[2 * d0 + 1], qn[d0], c[2 * tt + 1]); } }
        float rm = -1e30f;
#pragma unroll
        for (int q = 0; q < 4; ++q)
#pragma unroll
            for (int r = 0; r < 16; ++r) { const int n = 32 * q + crow(r, hi); const float v = (16 * n + 31 <= tok) ? c[q][r] : -INFINITY; c[q][r] = v; rm = __builtin_fmaxf(rm, v); }
        rm = swap32_max(rm); float sum = 0.f;
#pragma unroll
        for (int q = 0; q < 4; ++q)
#pragma unroll
            for (int r = 0; r < 16; ++r) { const float p = __builtin_amdgcn_exp2f(c[q][r] - rm); c[q][r] = p; sum += p; }
        sum = swap32_sum(sum); const float inv = sum > 0.f ? __builtin_amdgcn_rcpf(sum) : 0.f;
#pragma unroll
        for (int q = 0; q < 4; ++q)
#pragma unroll
            for (int r = 0; r < 16; ++r) c[q][r] *= inv;
#pragma unroll
        for (int r = 0; r < 16; ++r) { out0[r] = 0.f; out1[r] = 0.f; }
        pv_tile(out0, out1, c[0], c[1], kv, lane); pv_tile(out0, out1, c[2], c[3], kv + 16384, lane);
#pragma unroll
        for (int r = 0; r < 16; ++r) { out0[r] *= gate[0]; out1[r] *= gate[0]; }
#pragma unroll
        for (int q = 0; q < 4; ++q)
#pragma unroll
            for (int r = 0; r < 16; ++r) { float v = c[q][r]; v += __shfl_xor(v, 1); v += __shfl_xor(v, 2); if (hr == 0) psum[(32 * q + crow(r, hi)) * 8 + ql] = v; }
        asm volatile("s_waitcnt lgkmcnt(0)" ::: "memory");
        { const int q = lane & 7, jj = lane >> 3; float val[4];
#pragma unroll
          for (int k = 0; k < 4; ++k) { const int j = jj + 8 * k; float s = 0.f;
#pragma unroll
              for (int n = 4 * j - 1; n <= 4 * j + 3; ++n) if (n >= 0) s += psum[n * 8 + q];
              const bool adm = j <= jq, forced = (j == 0) || (j == jq); val[k] = adm ? (forced ? 1e4f : s) : -1e30f; impw[q * 32 + j] = val[k]; }
          asm volatile("s_waitcnt lgkmcnt(0)" ::: "memory");
          int rank[4] = {0, 0, 0, 0};
#pragma unroll
          for (int j4 = 0; j4 < 8; ++j4) { const f32x4 o = *(const LAS f32x4*)(impw + q * 32 + 4 * j4);
#pragma unroll
              for (int e = 0; e < 4; ++e) { const int jo = 4 * j4 + e;
#pragma unroll
                  for (int k = 0; k < 4; ++k) { const int j = jj + 8 * k; rank[k] += (o[e] > val[k] || (o[e] == val[k] && jo < j)) ? 1 : 0; } } }
          unsigned bits = 0u;
#pragma unroll
          for (int k = 0; k < 4; ++k) { const int j = jj + 8 * k; if (j <= jq && rank[k] < 8) bits |= 1u << j; }
          bits |= __shfl_xor(bits, 8); bits |= __shfl_xor(bits, 16); bits |= __shfl_xor(bits, 32);
          sel = __shfl(bits, ql); }
        __syncthreads();
    }
    bf16x8 qr[4];
#pragma unroll
    for (int d0 = 0; d0 < 4; ++d0) qr[d0] = scale_q(*(const bf16x8*)(qrot + row * 768 + h * 64 + 16 * d0 + 8 * hi));
    { AttnAcc A; acc_init(A); SlcMF mf{sel, jq, trel};
      attn_run(A, qr, zb + E_KS + g * 64, ZLD, zb + E_VS + g * 64, ZLD, 0, jq + 1, mf, kv, wid, lane);
      const float sc = acc_inv(A) * gate[1];
#pragma unroll
      for (int r = 0; r < 16; ++r) { out0[r] += A.o0[r] * sc; out1[r] += A.o1[r] * sc; } }
    { AttnAcc A; acc_init(A); WinMF mf{jq, trel};
      attn_run(A, qr, zb + E_KW + g * 64, ZLD, zb + E_VW + g * 64, ZLD, jq >= 8 ? jq - 8 : 0, jq + 1, mf, kv, wid, lane);
      const float sc = acc_inv(A) * gate[2];
#pragma unroll
      for (int r = 0; r < 16; ++r) { out0[r] += A.o0[r] * sc; out1[r] += A.o1[r] * sc; } }
    store_rows(wsb(a, wsm::MIX) + row * 1024 + 256 + h * 64, out0, out1, 1.0f, hi);
}

__device__ __forceinline__ unsigned order_key(float f) { unsigned u = __float_as_uint(f); if ((u << 1) == 0u) u = 0u; return u ^ ((u >> 31) ? 0xFFFFFFFFu : 0x80000000u); }
__device__ __forceinline__ float key_val(unsigned k) { return __uint_as_float(k >= 0x80000000u ? (k ^ 0x80000000u) : ~k); }
__device__ __forceinline__ unsigned xq_sum(unsigned c, LAS unsigned* buf, int par, int wid, int fr, int fq) {
    c += __shfl_xor(c, 16); c += __shfl_xor(c, 32);
    if (fq == 0) buf[par * 128 + wid * 16 + fr] = c;
    asm volatile("s_waitcnt lgkmcnt(0)" ::: "memory"); __syncthreads();
    unsigned r = 0u;
#pragma unroll
    for (int w = 0; w < 8; ++w) r += buf[par * 128 + w * 16 + fr];
    return r;
}
__device__ __forceinline__ void xq_4(unsigned& s0, unsigned& s1, unsigned& mx, unsigned& mn, LAS unsigned* buf, int wid, int fr, int fq) {
    s0 += __shfl_xor(s0, 16); s0 += __shfl_xor(s0, 32); s1 += __shfl_xor(s1, 16); s1 += __shfl_xor(s1, 32);
    { unsigned o = __shfl_xor(mx, 16); mx = mx > o ? mx : o; o = __shfl_xor(mx, 32); mx = mx > o ? mx : o; o = __shfl_xor(mn, 16); mn = mn < o ? mn : o; o = __shfl_xor(mn, 32); mn = mn < o ? mn : o; }
    if (fq == 0) { buf[wid * 64 + fr] = s0; buf[wid * 64 + 16 + fr] = s1; buf[wid * 64 + 32 + fr] = mx; buf[wid * 64 + 48 + fr] = mn; }
    asm volatile("s_waitcnt lgkmcnt(0)" ::: "memory"); __syncthreads();
    s0 = 0u; s1 = 0u; mx = 0u; mn = 0xFFFFFFFFu;
#pragma unroll
    for (int w = 0; w < 8; ++w) { s0 += buf[w * 64 + fr]; s1 += buf[w * 64 + 16 + fr]; const unsigned a = buf[w * 64 + 32 + fr], b = buf[w * 64 + 48 + fr]; mx = mx > a ? mx : a; mn = mn < b ? mn : b; }
}
__device__ __forceinline__ void dsa_select_unit(const Args& a, int b, int qt, ldsp lds) {
    const int tid = otid(), wid = __builtin_amdgcn_readfirstlane(tid >> 6), lane = tid & 63, fr = lane & 15, fq = lane >> 4;
    const bf16_t* zb = wsb(a, wsm::ACTZ) + (size_t)b * S * ZLD; const int t0 = qt * 16, t = t0 + fr; const int nW = (t0 + 15) / 32 + 1;
#ifdef PROBE_SUB
    if (PROBE_SUB == 25) {
        bool bad = false; for (int key = tid; key <= t0 + 15; key += 512) { const u32x4 w = *(const u32x4*)(zb + (size_t)key * ZLD + O_KI); if ((w[0] ^ w[1] ^ w[2] ^ w[3]) != ((const unsigned*)(a.ws + wsm::END))[(size_t)b * S + key]) bad = true; }
        const unsigned long long bm = __ballot(bad); if (bm && (threadIdx.x & 63) == 0) atomicAdd((unsigned*)(a.ws + wsm::CTL) + 4000, (unsigned)__popcll(bm)); }
#endif
    LAS unsigned* cbuf = (LAS unsigned*)lds;
    LAS unsigned* xbuf = (LAS unsigned*)(lds + 1024);
    bf16x8 bq[4]; float wq[4];
#pragma unroll
    for (int h = 0; h < 4; ++h) { bq[h] = *(const bf16x8*)(zb + (size_t)t * ZLD + O_QI + h * 32 + 8 * fq); wq[h] = bf2f(zb[(size_t)t * ZLD + O_WI + h]); }
    SUBT_BEGIN(1);
    unsigned U[8][8];
    const int trel = t - 4 * fq;
#pragma unroll
    for (int kh4 = 0; kh4 < 2; ++kh4) { bf16x8 af[4][2];
#pragma unroll
      for (int k4 = 0; k4 < 4; ++k4)
#pragma unroll
          for (int hf = 0; hf < 2; ++hf) { const int word = wid + 8 * (4 * kh4 + k4); const int kb = word < nW ? 32 * word + 16 * hf : 0; af[k4][hf] = *(const bf16x8*)(zb + (size_t)(kb + fr) * ZLD + O_KI + 8 * fq); }
#pragma unroll
      for (int k4 = 0; k4 < 4; ++k4) { const int k = 4 * kh4 + k4, word = wid + 8 * k;
#pragma unroll
          for (int hf = 0; hf < 2; ++hf) { const int kb = 32 * word + 16 * hf;
              f32x4 sc = {0.f, 0.f, 0.f, 0.f};
#pragma unroll
              for (int h = 0; h < 4; ++h) { const f32x4 zero = {0.f, 0.f, 0.f, 0.f}; const f32x4 cc = MFMA16(af[k4][hf], bq[h], zero);
#pragma unroll
                  for (int i = 0; i < 4; ++i) sc[i] += wq[h] * __builtin_fmaxf(cc[i], 0.f); }
#pragma unroll
              for (int i = 0; i < 4; ++i) { U[k][4 * hf + i] = (word < nW && kb + i <= trel) ? order_key(sc[i]) : 0u; asm volatile("" : "+v"(U[k][4 * hf + i])); } }
          __builtin_amdgcn_sched_barrier(0); }
      __builtin_amdgcn_sched_barrier(0); }
#ifdef PROBE_SUB
#ifndef CHK20_TOL
#define CHK20_TOL 1e-3f
#endif
    if (PROBE_SUB == 20) {
        unsigned* dump = (unsigned*)(a.ws + wsm::END) + ((size_t)blockIdx.x * 512 + tid) * 64;
#pragma unroll
        for (int k = 0; k < 8; ++k)
#pragma unroll
            for (int i = 0; i < 8; ++i) dump[k * 8 + i] = U[k][i];
        bool bad = false; int nbadk = 0;
        if ((fr & 3) == (qt & 3)) for (int idx = 0; idx < 64; ++idx) { const int k = idx >> 3, ii = idx & 7, word = wid + 8 * k, key = 32 * word + 16 * (ii >> 2) + 4 * fq + (ii & 3);
            if (word < nW && key <= t) { float sc = 0.f;
                for (int h = 0; h < 4; ++h) { float lg = 0.f; for (int d = 0; d < 32; ++d) lg += bf2f(zb[(size_t)t * ZLD + O_QI + h * 32 + d]) * bf2f(zb[(size_t)key * ZLD + O_KI + d]); sc += wq[h] * __builtin_fmaxf(lg, 0.f); }
#ifdef CHK20_TWICE
                float sc2 = 0.f; asm volatile("" ::: "memory");
                for (int h = 0; h < 4; ++h) { float lg = 0.f; for (int d = 31; d >= 0; --d) lg += bf2f(zb[(size_t)t * ZLD + O_QI + h * 32 + d]) * bf2f(zb[(size_t)key * ZLD + O_KI + d]); sc2 += wq[h] * __builtin_fmaxf(lg, 0.f); }
                const float got = sc2;
#else
                const float got = key_val(dump[idx]);
#endif
                if (!(__builtin_fabsf(got - sc) <= CHK20_TOL * (1.0f + __builtin_fabsf(sc)))) { bad = true; ++nbadk; } } }
#ifdef CHK20_KEYS
        if (nbadk) atomicAdd((unsigned*)(a.ws + wsm::CTL) + 4000, (unsigned)nbadk);
#else
        { const unsigned long long bm = __ballot(bad); if (bm && (threadIdx.x & 63) == 0) atomicAdd((unsigned*)(a.ws + wsm::CTL) + 4000, (unsigned)__popcll(bm)); }
#endif (word 4000 of the per-launch zeroed control block)
    }
#endif
    SUBT_END(1, lds); SUBT_BEGIN(2);
#define DSA_CNT(EXPR, OUT) do { unsigned c_ = 0u; _Pragma("unroll") for (int k = 0; k < 8; ++k) if (wid + 8 * k < nW) { _Pragma("unroll") for (int i = 0; i < 8; ++i) { const unsigned u = U[k][i]; \
        const int kc = 32 * (wid + 8 * k) + 16 * (i >> 2) + (i & 3); (void)kc; (void)u; c_ += (EXPR) ? 1u : 0u; } } OUT = c_; } while (0)
    unsigned T = 0u; int I = 2047;
    if (t0 + 16 > 256) {
        const bool need = t >= 256;
        unsigned cge, cgt, kmx = 0u, kmn = 0xFFFFFFFFu;
        DSA_CNT(u >= 0x80000000u, cge); DSA_CNT(u > 0x80000000u, cgt);
#pragma unroll
        for (int k = 0; k < 8; ++k)
#pragma unroll
            for (int i = 0; i < 8; ++i) { const unsigned u = U[k][i]; kmx = u > kmx ? u : kmx; kmn = (u != 0u && u < kmn) ? u : kmn; }
        xq_4(cge, cgt, kmx, kmn, xbuf, wid, fr, fq);
        unsigned kl = 0u, kh = 2u, cl = 257u, ch = 0u; bool done = !need, tie = false;
        if (!need) {}
        else if (cgt >= 256u) { kl = 0x80000001u; cl = cgt; kh = kmx + 1u; ch = 0u; if (cgt == 256u) { T = kl; done = true; } }
        else if (cge >= 256u) { kl = 0x80000000u; cl = cge; kh = 0x80000001u; ch = cgt; if (cge == 256u) { T = kl; done = true; } }
        else { kl = kmn; cl = (unsigned)(t + 1); kh = 0x80000000u; ch = cge; }
        if (!done && kh - kl == 1u) { T = kl; tie = true; done = true; }
#ifdef SEL_NOGALLOP
        int fre = 0, side = 0, it = 0;
#else
        int fre = !need ? 0 : (kl == 0x80000001u ? 1 : (kh == 0x80000000u ? 2 : 0)), side = 0, it = 0;
#endif
        float rl = (float)cl - 256.0f, rh = (float)ch - 256.0f;
#ifndef SEL_CAND
#define SEL_CAND 32u
#endif
        while (!__all(done || (cl - ch) <= SEL_CAND)) {
            unsigned km; const unsigned mid = kl + ((kh - kl) >> 1);
            if (fre == 1) km = (kh - kl > 0x01000000u) ? kh - 0x01000000u : mid;
            else if (fre == 2) km = (kh - kl > 0x01000000u) ? kl + 0x01000000u : mid;
            else km = kl + (unsigned)((float)(kh - kl) * (rl / (rl - rh)));
            km = km <= kl ? kl + 1u : km; km = km >= kh ? kh - 1u : km;
            unsigned c; DSA_CNT(u >= km, c); c = xq_sum(c, cbuf, it & 1, wid, fr, fq);
            if (!done) { if (c == 256u) { T = km; done = true; }
                else if (c > 256u) { kl = km; cl = c; rl = (float)c - 256.0f; if (fre == 1) { fre = 0; side = 0; } else { if (side == 1) rh *= 0.5f; side = 1; } }
                else { kh = km; ch = c; rh = (float)c - 256.0f; if (fre == 2) { fre = 0; side = 0; } else { if (side == 2) rl *= 0.5f; side = 2; } }
                if (!done && kh - kl == 1u) { T = kl; tie = true; done = true; } }
            ++it;
        }
#ifdef PROBE_SUB
        if (PROBE_SUB == 7 && threadIdx.x == 0) *(LAS unsigned*)(lds + cfg::LDS_BYTES - 8) += (unsigned)it * 100u;
#endif
        if (!__all(done)) {
            LAS unsigned* lcnt = (LAS unsigned*)(lds + 4096); LAS unsigned* linf = lcnt + 16; LAS unsigned* lres = linf + 64; LAS unsigned* list = (LAS unsigned*)(lds + 8192);
            __syncthreads();
            if (wid == 0 && fq == 0) { lcnt[fr] = 0u; linf[fr * 4 + 2] = 256u - ch; linf[fr * 4 + 3] = done ? 0u : 1u; lres[fr * 4 + 3] = 0u; }
            __syncthreads();
            { const bool act = !done;
#pragma unroll
              for (int k = 0; k < 8; ++k) if (wid + 8 * k < nW) {
#pragma unroll
                  for (int i = 0; i < 8; ++i) { const unsigned u = U[k][i]; const bool inb = act && u >= kl && u < kh;
                      if (__any(inb)) { if (inb) { const unsigned pos = __hip_atomic_fetch_add(lcnt + fr, 1u, __ATOMIC_RELAXED, __HIP_MEMORY_SCOPE_WORKGROUP); if (pos < 32u) list[fr * 32 + pos] = u; } } } } }
            asm volatile("s_waitcnt lgkmcnt(0)" ::: "memory"); __syncthreads();
            { const int q = tid >> 5, j = tid & 31; const unsigned n = lcnt[q] < 32u ? lcnt[q] : 32u;
              if (linf[q * 4 + 3] != 0u && (unsigned)j < n) { const unsigned rn = linf[q * 4 + 2], v = list[q * 32 + j]; unsigned gt = 0u, eq = 0u;
                  for (unsigned i = 0; i < n; ++i) { const unsigned w = list[q * 32 + i]; gt += w > v ? 1u : 0u; eq += w == v ? 1u : 0u; }
                  if (gt < rn && rn <= gt + eq) { lres[q * 4 + 0] = v; lres[q * 4 + 1] = gt; lres[q * 4 + 2] = eq; lres[q * 4 + 3] = 1u; } } }
            asm volatile("s_waitcnt lgkmcnt(0)" ::: "memory"); __syncthreads();
            if (!done) { T = lres[fr * 4 + 0]; ch += lres[fr * 4 + 1]; tie = lres[fr * 4 + 2] > 256u - ch; done = true; }
            __syncthreads();
        }
        const unsigned budget = 256u - ch;
        if (__any(tie)) { __syncthreads(); int lo = 0;
            for (int bit = 10; bit >= 0; --bit) { const int cand = lo | (1 << bit), crel = cand - 4 * fq; unsigned c; DSA_CNT(u == T && kc < crel, c); c = xq_sum(c, cbuf, bit & 1, wid, fr, fq); if (c < budget) lo = cand; }
            if (tie) I = lo; }
    }
#undef DSA_CNT
    SUBT_END(2, lds); SUBT_BEGIN(3);
    unsigned* mw = (unsigned*)(a.ws + wsm::DMASK) + ((size_t)b * S + t) * 64; const int Irel = I - 4 * fq;
#ifdef PROBE_SUB
    unsigned chk_pop = 0u;
#endif
#pragma unroll
    for (int k = 0; k < 8; ++k) { unsigned bits = 0u;
#pragma unroll
        for (int i = 0; i < 8; ++i) { const unsigned u = U[k][i]; const int kc = 32 * (wid + 8 * k) + 16 * (i >> 2) + (i & 3); const bool sl = (u != 0u) && (u > T || (u == T && kc <= Irel)); bits |= sl ? (1u << (16 * (i >> 2) + (i & 3))) : 0u; }
        bits <<= 4 * fq; bits |= __shfl_xor(bits, 16); bits |= __shfl_xor(bits, 32);
#ifdef PROBE_SUB
        if (PROBE_SUB == 8 && fq == 0) chk_pop += (unsigned)__popc(bits);
#endif
        if (fq == 0) mw[wid + 8 * k] = bits; }
    __syncthreads();
#ifdef PROBE_SUB
    if (PROBE_SUB == 8) {
        const unsigned tot = xq_sum(chk_pop, cbuf, 0, wid, fr, fq), want = (unsigned)(t + 1 < 256 ? t + 1 : 256);
        if (__any(tot != want) && threadIdx.x == 0) *(LAS unsigned*)(lds + cfg::LDS_BYTES - 8) += 10000u;
        __syncthreads(); }
#endif
    SUBT_END(3, lds);
}
__device__ __forceinline__ unsigned wave_umax(unsigned v) {
#pragma unroll
    for (int o = 32; o >= 1; o >>= 1) { const unsigned x = (unsigned)__shfl_xor((int)v, o); v = v > x ? v : x; } return v; }
__device__ __forceinline__ unsigned wave_umin(unsigned v) {
#pragma unroll
    for (int o = 32; o >= 1; o >>= 1) { const unsigned x = (unsigned)__shfl_xor((int)v, o); v = v < x ? v : x; } return v; }
__device__ __forceinline__ void dsa_select_unit2(const Args& a, int b, int qt, ldsp lds) {
    const int tid = otid(), wid = __builtin_amdgcn_readfirstlane(tid >> 6), lane = tid & 63, fr = lane & 15, fq = lane >> 4;
    const bf16_t* zb = wsb(a, wsm::ACTZ) + (size_t)b * S * ZLD; const int t0 = qt * 16, nW = (t0 + 15) / 32 + 1;
    LAS unsigned* SK = (LAS unsigned*)lds;
    constexpr int PITCH = 2049;
    SUBT_BEGIN(1);
    {
        const int t = t0 + fr, trel = t - 4 * fq;
        bf16x8 bq[4]; float wq[4];
#pragma unroll
        for (int h = 0; h < 4; ++h) { bq[h] = *(const bf16x8*)(zb + (size_t)t * ZLD + O_QI + h * 32 + 8 * fq); wq[h] = bf2f(zb[(size_t)t * ZLD + O_WI + h]); }
#pragma unroll
        for (int kh4 = 0; kh4 < 2; ++kh4) { bf16x8 af[4][2];
#pragma unroll
            for (int k4 = 0; k4 < 4; ++k4)
#pragma unroll
                for (int hf = 0; hf < 2; ++hf) { const int word = wid + 8 * (4 * kh4 + k4); const int kb = word < nW ? 32 * word + 16 * hf : 0; af[k4][hf] = *(const bf16x8*)(zb + (size_t)(kb + fr) * ZLD + O_KI + 8 * fq); }
#pragma unroll
            for (int k4 = 0; k4 < 4; ++k4) { const int word = wid + 8 * (4 * kh4 + k4);
                if (word < nW) {
#pragma unroll
                    for (int hf = 0; hf < 2; ++hf) { const int kb = 32 * word + 16 * hf;
                        f32x4 sc = {0.f, 0.f, 0.f, 0.f};
#pragma unroll
                        for (int h = 0; h < 4; ++h) { const f32x4 zero = {0.f, 0.f, 0.f, 0.f}; const f32x4 cc = MFMA16(af[k4][hf], bq[h], zero);
#pragma unroll
                            for (int i = 0; i < 4; ++i) sc[i] += wq[h] * __builtin_fmaxf(cc[i], 0.f); }
#pragma unroll
                        for (int i = 0; i < 4; ++i) SK[fr * PITCH + kb + 4 * fq + i] = (kb + i <= trel) ? order_key(sc[i]) : 0u; } }
                __builtin_amdgcn_sched_barrier(0); }
            __builtin_amdgcn_sched_barrier(0); }
    }
    asm volatile("s_waitcnt lgkmcnt(0)" ::: "memory"); __syncthreads();
    SUBT_END(1, lds); SUBT_BEGIN(2);
#pragma unroll 1
    for (int qq = 0; qq < 2; ++qq) {
        const int q = 2 * wid + qq, t = t0 + q, nj = t / 64 + 1;
        unsigned V[32];
#pragma unroll
        for (int j = 0; j < 32; ++j) V[j] = (j < nj && 64 * j + lane <= t) ? SK[q * PITCH + 64 * j + lane] : 0u;
#define WCNT_(J0, J1, EXPR) _Pragma("unroll") for (int j = J0; j < J1; ++j) { const unsigned u = V[j]; const int key = 64 * j + lane; (void)key; (void)u; c_ += (unsigned)__popcll(__ballot(EXPR)); }
#define WCNT(EXPR, OUT) do { unsigned c_ = 0u; WCNT_(0, 8, EXPR) if (nj > 8) { WCNT_(8, 16, EXPR) if (nj > 16) { WCNT_(16, 32, EXPR) } } OUT = c_; } while (0)
        unsigned T = 0u; int I = 2047;
        bool tie = false;
        if (t >= 256) {
            unsigned cgt; WCNT(u > 0x80000000u, cgt);
            unsigned kl, kh, cl, ch; bool done = false; int fre = 0;
            if (cgt >= 256u) {
                unsigned mx = 0u;
#pragma unroll
                for (int j = 0; j < 32; ++j) mx = V[j] > mx ? V[j] : mx;
                kl = 0x80000001u; cl = cgt; kh = wave_umax(mx) + 1u; ch = 0u; fre = 1; if (cgt == 256u) { T = kl; done = true; } }
            else { unsigned cge; WCNT(u >= 0x80000000u, cge);
                if (cge >= 256u) { kl = 0x80000000u; cl = cge; kh = 0x80000001u; ch = cgt; if (cge == 256u) { T = kl; done = true; } }
                else { unsigned mn = 0xFFFFFFFFu;
#pragma unroll
                    for (int j = 0; j < 32; ++j) mn = (V[j] != 0u && V[j] < mn) ? V[j] : mn;
                    kl = wave_umin(mn); cl = (unsigned)(t + 1); kh = 0x80000000u; ch = cge; fre = 2; } }
            if (!done && kh - kl == 1u) { T = kl; tie = true; done = true; }
            float rl = (float)cl - 256.0f, rh = (float)ch - 256.0f; int side = 0;
            while (!done) {
                unsigned km; const unsigned mid = kl + ((kh - kl) >> 1);
                if (fre == 1) km = (kh - kl > 0x01000000u) ? kh - 0x01000000u : mid;
                else if (fre == 2) km = (kh - kl > 0x01000000u) ? kl + 0x01000000u : mid;
                else km = kl + (unsigned)((float)(kh - kl) * (rl / (rl - rh)));
                km = km <= kl ? kl + 1u : km; km = km >= kh ? kh - 1u : km;
                unsigned c; WCNT(u >= km, c);
                if (c == 256u) { T = km; done = true; }
                else if (c > 256u) { kl = km; cl = c; rl = (float)c - 256.0f; if (fre == 1) { fre = 0; side = 0; } else { if (side == 1) rh *= 0.5f; side = 1; } }
                else { kh = km; ch = c; rh = (float)c - 256.0f; if (fre == 2) { fre = 0; side = 0; } else { if (side == 2) rl *= 0.5f; side = 2; } }
                if (!done && kh - kl == 1u) { T = kl; tie = true; done = true; }
            }
            if (tie) { const unsigned budget = 256u - ch; int lo = 0;
                for (int bit = 10; bit >= 0; --bit) { const int cand = lo | (1 << bit); unsigned c; WCNT(u == T && key < cand, c); if (c < budget) lo = cand; }
                I = lo; }
        }
        unsigned myw = 0u;
        if (!tie) { const unsigned Tm = T > 1u ? T : 1u;
#pragma unroll
            for (int j = 0; j < 32; ++j) { const unsigned long long bal = __ballot(V[j] >= Tm); myw = lane == 2 * j ? (unsigned)bal : myw; myw = lane == 2 * j + 1 ? (unsigned)(bal >> 32) : myw; }
        } else {
#pragma unroll
            for (int j = 0; j < 32; ++j) { const unsigned u = V[j]; const unsigned long long bal = __ballot(u != 0u && (u > T || (u == T && 64 * j + lane <= I))); myw = lane == 2 * j ? (unsigned)bal : myw; myw = lane == 2 * j + 1 ? (unsigned)(bal >> 32) : myw; } }
        ((unsigned*)(a.ws + wsm::DMASK))[((size_t)b * S + t) * 64 + lane] = myw;
#undef WCNT
#undef WCNT_
    }
    __syncthreads();
    SUBT_END(2, lds);
}
__device__ __forceinline__ void kmean_unit(const Args& a, int u, ldsp lds) {
    const int tid = otid(), wid = tid >> 6, lane = tid & 63, b = u >> 3, j = u & 7; const bf16_t* p = wsb(a, wsm::ACTZ) + ((size_t)b * S + j * 256 + wid * 32) * ZLD + O_KD + lane * 8;
    float s[8] = {0.f, 0.f, 0.f, 0.f, 0.f, 0.f, 0.f, 0.f};
#pragma unroll 8
    for (int r = 0; r < 32; ++r) { const u32x4 w = *(const u32x4*)(p + (size_t)r * ZLD);
#pragma unroll
        for (int i = 0; i < 4; ++i) { s[2 * i] += bflo(w[i]); s[2 * i + 1] += bfhi(w[i]); } }
    LAS float* red = (LAS float*)lds;
#pragma unroll
    for (int i = 0; i < 8; ++i) red[wid * 512 + lane * 8 + i] = s[i];
    __syncthreads();
    { float t = 0.f;
#pragma unroll
      for (int w = 0; w < 8; ++w) t += red[w * 512 + tid];
      wsf(a, wsm::KMEAN)[((size_t)(b * 8 + (tid >> 6)) * 8 + j) * 64 + (tid & 63)] = t * (1.0f / 256.0f); }
    __syncthreads();
}

struct DsaMF { const unsigned* mw; unsigned w0, w1, n0, n1;
    __device__ __forceinline__ int prep(int t) { w0 = n0; w1 = n1; if (t < 31) { n0 = mw[2 * t + 2]; n1 = mw[2 * t + 3]; } return __any((w0 | w1) != 0u) ? 2 : 0; }
    __device__ __forceinline__ bool ok(int, int kr) const { return (((kr & 32) ? w1 : w0) >> (kr & 31)) & 1u; } };
__device__ __forceinline__ void dsa_attn_unit(const Args& a, int b, int qt, ldsp lds) {
    const int tid = otid(), wid = __builtin_amdgcn_readfirstlane(tid >> 6), lane = tid & 63, r32 = lane & 31, hi = lane >> 5;
    const int q0 = qt * 32, tok = q0 + r32; const size_t row = (size_t)b * S + tok; const bf16_t* z = wsb(a, wsm::ACTZ); const bf16_t* zb = z + (size_t)b * S * ZLD;
    bf16x8 qr[4];
#pragma unroll
    for (int d0 = 0; d0 < 4; ++d0) qr[d0] = scale_q(*(const bf16x8*)(z + row * ZLD + O_QC + wid * 64 + 16 * d0 + 8 * hi));
    const unsigned* mwp = (const unsigned*)(a.ws + wsm::DMASK) + row * 64; AttnAcc A; acc_init(A); DsaMF mf{mwp, 0u, 0u, mwp[0], mwp[1]};
    attn_run(A, qr, zb + O_KC, ZLD, zb + O_VC, ZLD, 0, q0 / 64 + 1, mf, lds, wid, lane);
    store_rows(wsb(a, wsm::MIX) + row * 1024 + wid * 64, A.o0, A.o1, acc_inv(A), hi);
}

struct MobaMF { unsigned sel; int own, wq, r32;
    __device__ __forceinline__ int prep(int t) const { const int jb = t >> 2;
        if (jb < own) { const bool bit = (sel >> jb) & 1u; if (!__any(bit)) return 0; return __all(bit) ? 1 : 2; }
        const int k0 = 64 * (t - 4 * own); if (k0 > wq + 31) return 0; return (k0 + 63 <= wq) ? 1 : 2; }
    __device__ __forceinline__ bool ok(int t, int kr) const { const int jb = t >> 2; return jb < own ? ((sel >> jb) & 1u) : (64 * (t - 4 * own) + kr <= wq + r32); } };
__device__ __forceinline__ void moba_unit(const Args& a, int b, int h, int own, ldsp lds) {
    const int tid = otid(), wid = __builtin_amdgcn_readfirstlane(tid >> 6), lane = tid & 63, r32 = lane & 31, hi = lane >> 5;
    const int tok = own * 256 + wid * 32 + r32; const size_t row = (size_t)b * S + tok; const bf16_t* z = wsb(a, wsm::ACTZ); const bf16_t* zb = z + (size_t)b * S * ZLD;
    bf16x8 qr[4];
#pragma unroll
    for (int d0 = 0; d0 < 4; ++d0) qr[d0] = scale_q(*(const bf16x8*)(z + row * ZLD + O_QD + h * 64 + 16 * d0 + 8 * hi));
    float gt[7]; const float* km = wsf(a, wsm::KMEAN) + (size_t)(b * 8 + h) * 8 * 64;
#pragma unroll
    for (int j = 0; j < 7; ++j) { float s = 0.f;
        if (j < own) {
#pragma unroll
            for (int d0 = 0; d0 < 4; ++d0) { const f32x4 k0 = *(const f32x4*)(km + j * 64 + 16 * d0 + 8 * hi), k1 = *(const f32x4*)(km + j * 64 + 16 * d0 + 8 * hi + 4); const u32x4 qw = __builtin_bit_cast(u32x4, qr[d0]);
                s += bflo(qw[0]) * k0[0] + bfhi(qw[0]) * k0[1] + bflo(qw[1]) * k0[2] + bfhi(qw[1]) * k0[3] + bflo(qw[2]) * k1[0] + bfhi(qw[2]) * k1[1] + bflo(qw[3]) * k1[2] + bfhi(qw[3]) * k1[3]; }
            s = swap32_sum(s); }
        gt[j] = s; }
    unsigned sel = 0u;
#pragma unroll
    for (int j = 0; j < 7; ++j) { int rank = 0;
#pragma unroll
        for (int j2 = 0; j2 < 7; ++j2) rank += (j2 < own && j2 != j && (gt[j2] > gt[j] || (gt[j2] == gt[j] && j2 < j))) ? 1 : 0;
        if (j < own && rank < 3) sel |= 1u << j; }
    AttnAcc A; acc_init(A); MobaMF mf{sel, own, wid * 32, r32};
    attn_run(A, qr, zb + O_KD + h * 64, ZLD, zb + O_VD + h * 64, ZLD, 0, 4 * own + 4, mf, lds, wid, lane);
    store_rows(wsb(a, wsm::MIX) + row * 1024 + 512 + h * 64, A.o0, A.o1, acc_inv(A), hi);
}
}
#ifdef PROBE_SUB
namespace chk {
#ifndef CHK_TOL
#define CHK_TOL 1e-3f
#endif
using namespace cfg;
typedef LAS char* ldsp;
__device__ __forceinline__ float wave_max(float v) { for (int o = 32; o >= 1; o >>= 1) v = __builtin_fmaxf(v, __shfl_xor(v, o)); return v; }
__device__ __forceinline__ float wave_sum(float v) { for (int o = 32; o >= 1; o >>= 1) v += __shfl_xor(v, o); return v; }
__device__ __forceinline__ float dot64(const bf16_t* a, const bf16_t* b) { float s = 0.f; for (int d = 0; d < 64; ++d) s += bf2f(a[d]) * bf2f(b[d]); return s; }
__device__ __forceinline__ unsigned hash32(unsigned x) { x ^= x >> 16; x *= 0x7feb352dU; x ^= x >> 15; x *= 0x846ca68bU; x ^= x >> 16; return x; }
__device__ __forceinline__ void flag_bad(ldsp lds, bool bad, int cls) { if ((PROBE_SUB == cls || (PROBE_SUB == 12 && cls == 9)) && __any(bad) && (threadIdx.x & 63) == 0) __hip_atomic_fetch_add((LAS unsigned*)(lds + LDS_BYTES - 8), 10000u, __ATOMIC_RELAXED, __HIP_MEMORY_SCOPE_WORKGROUP); }
__device__ __forceinline__ bool differs(float got, float ref) { return !(__builtin_fabsf(got - ref) <= 0.004f + 0.03f * __builtin_fabsf(ref)); }
template <class OK> __device__ __forceinline__ float naive_attn(const bf16_t* q, const bf16_t* K, int ldk, const bf16_t* V, int ldv, int nkeys, int d0, const OK& ok, int lane) {
    float m = -INFINITY;
    for (int s = lane; s < nkeys; s += 64) if (ok(s)) m = __builtin_fmaxf(m, 0.125f * dot64(q, K + (size_t)s * ldk));
    m = wave_max(m); if (!(m > -INFINITY)) return 0.f;
    float l = 0.f, o = 0.f;
    for (int s = lane; s < nkeys; s += 64) if (ok(s)) { const float p = __expf(0.125f * dot64(q, K + (size_t)s * ldk) - m); l += p; o += p * bf2f(V[(size_t)s * ldv + d0]); }
    l = wave_sum(l); o = wave_sum(o); return o / l;
}
struct DsaOk { const unsigned* mw; int t; __device__ __forceinline__ bool operator()(int s) const { return s <= t && ((mw[s >> 5] >> (s & 31)) & 1u); } };
struct MobaOk { unsigned sel; int own, t; __device__ __forceinline__ bool operator()(int s) const { const int j = s >> 8; return j < own ? ((sel >> j) & 1u) : (j == own && s <= t); } };
__device__ __forceinline__ void check_odd(const Args& a, ldsp lds, int mode) {
    const int tid_ = ph::otid(), lane = tid_ & 63, wv = blockIdx.x * 8 + (tid_ >> 6); const bf16_t* z = ph::wsb(a, wsm::ACTZ); const bf16_t* mix = ph::wsb(a, wsm::MIX);
    for (int rep = 0; rep < 2; ++rep) { const unsigned hsh = hash32((unsigned)(wv * 4 + rep) * 2654435761u + 12345u); const int b = hsh & 15, t = (hsh >> 4) & 2047, h = (hsh >> 15) & 7, d0 = ((hsh >> 18) + (mode == 12 ? 1 : 0)) & 63;
        const size_t row = (size_t)b * S + t; const bf16_t* zb = z + (size_t)b * S * ZLD;
        {
          const unsigned* mw = (const unsigned*)(a.ws + wsm::DMASK) + row * 64; DsaOk ok{mw, t};
          const float ref = naive_attn(z + row * ZLD + O_QC + h * 64, zb + O_KC, ZLD, zb + O_VC, ZLD, t + 1, d0, ok, lane);
          flag_bad(lds, differs(bf2f(mix[row * 1024 + h * 64 + d0]), ref), 9);
          float mn_sel = INFINITY, mx_uns = -INFINITY; int cnt = 0;
          for (int s = lane; s <= t; s += 64) { float sc = 0.f;
              for (int hh = 0; hh < 4; ++hh) { float lg = 0.f; for (int d = 0; d < 32; ++d) lg += bf2f(z[row * ZLD + O_QI + hh * 32 + d]) * bf2f(zb[(size_t)s * ZLD + O_KI + d]); sc += bf2f(z[row * ZLD + O_WI + hh]) * __builtin_fmaxf(lg, 0.f); }
              if ((mw[s >> 5] >> (s & 31)) & 1u) { mn_sel = __builtin_fminf(mn_sel, sc); ++cnt; } else mx_uns = __builtin_fmaxf(mx_uns, sc); }
          mn_sel = -wave_max(-mn_sel); mx_uns = wave_max(mx_uns); cnt = (int)wave_sum((float)cnt);
          const bool badcnt = cnt != (t + 1 < 256 ? t + 1 : 256), badord = (mx_uns > -INFINITY && mn_sel < mx_uns - CHK_TOL * (1.0f + __builtin_fabsf(mx_uns)));
          if (PROBE_SUB == 21 || PROBE_SUB == 22 || PROBE_SUB == 23) {
              unsigned Tn = 0u;
              for (int bit = 31; bit >= 0; --bit) { const unsigned cand = Tn | (1u << bit); int c = 0;
                  for (int s = lane; s <= t; s += 64) { float sc = 0.f;
                      for (int hh = 0; hh < 4; ++hh) { float lg = 0.f; for (int d = 0; d < 32; ++d) lg += bf2f(z[row * ZLD + O_QI + hh * 32 + d]) * bf2f(zb[(size_t)s * ZLD + O_KI + d]); sc += bf2f(z[row * ZLD + O_WI + hh]) * __builtin_fmaxf(lg, 0.f); }
                      c += ph::order_key(sc) >= cand ? 1 : 0; }
                  c = (int)wave_sum((float)c); if (c >= 256) Tn = cand; }
              int nm = 0, nfar = 0;
              for (int s = lane; s <= t; s += 64) { float sc = 0.f;
                  for (int hh = 0; hh < 4; ++hh) { float lg = 0.f; for (int d = 0; d < 32; ++d) lg += bf2f(z[row * ZLD + O_QI + hh * 32 + d]) * bf2f(zb[(size_t)s * ZLD + O_KI + d]); sc += bf2f(z[row * ZLD + O_WI + hh]) * __builtin_fmaxf(lg, 0.f); }
                  const unsigned kk = ph::order_key(sc); const bool fs = (mw[s >> 5] >> (s & 31)) & 1u;
                  if (kk != Tn && fs != (kk > Tn)) { ++nm; const float tv = ph::key_val(Tn); if (__builtin_fabsf(sc - tv) > 1e-3f * (1.0f + __builtin_fabsf(tv))) ++nfar; } }
              nm = (int)wave_sum((float)nm); nfar = (int)wave_sum((float)nfar);
              flag_bad(lds, t >= 256 && nm > 0, 21); flag_bad(lds, t >= 256 && nfar > 0, 22); flag_bad(lds, nm + nfar > 100000, 23); }
          flag_bad(lds, badcnt || badord, 10); flag_bad(lds, badcnt, 16); flag_bad(lds, badord && t >= 600, 18); flag_bad(lds, badord && t < 600, 19); }
        {
          const int own = t >> 8; const float* km = ph::wsf(a, wsm::KMEAN) + (size_t)(b * 8 + h) * 8 * 64; const bf16_t* q = z + row * ZLD + O_QD + h * 64; float gt[7];
#pragma unroll
          for (int j = 0; j < 7; ++j) { float s = 0.f; if (j < own) for (int d = 0; d < 64; ++d) s += bf2f(q[d]) * km[j * 64 + d]; gt[j] = s; }
          unsigned sel = 0u;
#pragma unroll
          for (int j = 0; j < 7; ++j) { int rank = 0;
#pragma unroll
              for (int j2 = 0; j2 < 7; ++j2) rank += (j2 < own && j2 != j && (gt[j2] > gt[j] || (gt[j2] == gt[j] && j2 < j))) ? 1 : 0;
              if (j < own && rank < 3) sel |= 1u << j; }
          MobaOk ok{sel, own, t};
          const float ref = naive_attn(q, zb + O_KD + h * 64, ZLD, zb + O_VD + h * 64, ZLD, t + 1, d0, ok, lane);
          flag_bad(lds, differs(bf2f(mix[row * 1024 + 512 + h * 64 + d0]), ref), 11); }
    }
}
struct SlcOk { unsigned sel; int t; __device__ __forceinline__ bool operator()(int s) const { return s <= t && ((sel >> (s >> 6)) & 1u); } };
struct WinOk { int t; __device__ __forceinline__ bool operator()(int s) const { return s <= t && s > t - 512; } };
struct CmpOk { int t; __device__ __forceinline__ bool operator()(int n) const { return n < 127 && 16 * n + 31 <= t; } };
__device__ __forceinline__ void check_even(const Args& a, ldsp lds, int mode) {
    const int tid_ = ph::otid(), lane = tid_ & 63, wid = tid_ >> 6, wv = blockIdx.x * 8 + wid; const bf16_t* z = ph::wsb(a, wsm::ACTZ); const bf16_t* mix = ph::wsb(a, wsm::MIX); const bf16_t* qrot = ph::wsb(a, wsm::QROT);
    LAS float* ps = (LAS float*)(lds + 4096) + wid * 160;
    for (int rep = 0; rep < 2; ++rep) { const unsigned hsh = hash32((unsigned)(wv * 4 + rep) * 2246822519u + 777u); const int b = hsh & 15, t = (hsh >> 4) & 2047, h = ((hsh >> 15) & 15) % 12, d0 = ((hsh >> 19) + (mode == 12 ? 1 : 0)) & 63, g = h >> 2;
        const size_t row = (size_t)b * S + t; const bf16_t* zb = z + (size_t)b * S * ZLD; const bf16_t* Kc = ph::wsb(a, wsm::KCMP) + (size_t)(b * 3 + g) * 128 * 64; const bf16_t* Vc = ph::wsb(a, wsm::VCMP) + (size_t)(b * 3 + g) * 128 * 64;
        float p0 = 0.f, p1 = 0.f; CmpOk cok{t};
        for (int r = 0; r < 4; ++r) { const bf16_t* qn = z + row * ZLD + E_Q + (4 * g + r) * 64; const float s0 = cok(lane) ? 0.125f * dot64(qn, Kc + (size_t)lane * 64) : -INFINITY, s1 = cok(lane + 64) ? 0.125f * dot64(qn, Kc + (size_t)(lane + 64) * 64) : -INFINITY;
            const float m = wave_max(__builtin_fmaxf(s0, s1)); if (m > -INFINITY) { const float e0 = __expf(s0 - m), e1 = __expf(s1 - m), l = wave_sum(e0 + e1); p0 += e0 / l; p1 += e1 / l; } }
        ps[lane] = p0; ps[lane + 64] = p1; asm volatile("s_waitcnt lgkmcnt(0)" ::: "memory");
        const int jq = t >> 6;
        if (lane < 32) { const int j = lane; float s = 0.f; for (int n = 4 * j - 1; n <= 4 * j + 3; ++n) if (n >= 0 && n < 128) s += ps[n]; ps[128 + j] = j <= jq ? ((j == 0 || j == jq) ? 1e4f : s) : -1e30f; }
        asm volatile("s_waitcnt lgkmcnt(0)" ::: "memory");
        bool mine = false; if (lane < 32) { const float v = ps[128 + lane]; int rank = 0; for (int j2 = 0; j2 < 32; ++j2) { const float o = ps[128 + j2]; rank += (o > v || (o == v && j2 < lane)) ? 1 : 0; } mine = lane <= jq && rank < 8; }
        const unsigned sel = (unsigned)__ballot(mine);
        const bf16_t* qn = z + row * ZLD + E_Q + h * 64; const bf16_t* qr = qrot + row * 768 + h * 64;
        const float oc = naive_attn(qn, Kc, 64, Vc, 64, 128, d0, cok, lane);
        SlcOk sok{sel, t}; const float os = naive_attn(qr, zb + E_KS + g * 64, ZLD, zb + E_VS + g * 64, ZLD, t + 1, d0, sok, lane);
        WinOk wok{t}; const float ow = naive_attn(qr, zb + E_KW + g * 64, ZLD, zb + E_VW + g * 64, ZLD, t + 1, d0, wok, lane);
        const float g0_ = 1.0f / (1.0f + __expf(-bf2f(z[row * ZLD + E_GL + h * 3 + 0]))), g1_ = 1.0f / (1.0f + __expf(-bf2f(z[row * ZLD + E_GL + h * 3 + 1]))), g2_ = 1.0f / (1.0f + __expf(-bf2f(z[row * ZLD + E_GL + h * 3 + 2])));
        const float ref = g0_ * oc + g1_ * os + g2_ * ow;
        flag_bad(lds, differs(bf2f(mix[row * 1024 + 256 + h * 64 + d0]), ref), 14);
        if (rep == 0 && (wv & 15) == 0) { const int kv = (hsh >> 25) & 1, n = ((hsh >> 26) & 63) * 2 % 127, dd = (hsh >> 19) & 63; const float* pe = a.in[kv ? 18 : 15]; const float* w1 = a.in[kv ? 19 : 16]; const float* w2 = a.in[kv ? 20 : 17]; float acc = 0.f;
          for (int c = lane; c < 256; c += 64) { float hsum = 0.f;
              for (int kk = 0; kk < 2048; ++kk) { const int l = kk >> 6, d = kk & 63; hsum += (bf2f(zb[(size_t)(16 * n + l) * ZLD + (kv ? E_VC : E_KC) + g * 64 + d]) + pe[kk]) * w1[(size_t)kk * 256 + c]; }
              acc += gelu_tanh(hsum) * w2[c * 64 + dd]; }
          acc = wave_sum(acc);
          flag_bad(lds, differs(bf2f((kv ? Vc : Kc)[(size_t)n * 64 + dd]), acc), 15); }
    }
}
}
#endif

#define XB_TMO      128
#define XB_XCNT(j)  (256  + 64 * (j))
#define XB_XSUB(j)  (1280 + 64 * (j))
#define XB_XGEN(j)  (2304 + 64 * (j))
#define XB_TOP      3328
#define XB_TOPGEN   3392
#define XCD_BAR_WORDS 3456
#define XB_SPIN_CAP (1u << 18)
#define LAS __attribute__((address_space(3)))

__device__ __forceinline__ unsigned xb_ld(unsigned* p)              { return __hip_atomic_load(p, __ATOMIC_RELAXED, __HIP_MEMORY_SCOPE_AGENT); }
__device__ __forceinline__ unsigned xb_add(unsigned* p, unsigned v) { return __hip_atomic_fetch_add(p, v, __ATOMIC_RELAXED, __HIP_MEMORY_SCOPE_AGENT); }
__device__ __forceinline__ unsigned xb_xcc_id() { return (unsigned)__builtin_amdgcn_s_getreg((3 << 11) | 20) & 0xFu; }
#define XB_SPIN(cond, bar) do { unsigned _sp = 0; while (cond) { __builtin_amdgcn_s_sleep(1); \
    if ((++_sp & 255u) == 0u) { if (xb_ld(&(bar)[XB_TMO])) break; if (_sp > XB_SPIN_CAP) { atomicAdd(&(bar)[XB_TMO], 1u); break; } } } } while (0)

struct XcdBarrier {
    unsigned* bar; unsigned x;
    volatile LAS unsigned* st;
};

__device__ __forceinline__ XcdBarrier xcd_barrier_post(unsigned* bar, volatile LAS unsigned* st) {
    XcdBarrier b; b.bar = bar; b.x = xb_xcc_id(); b.st = st;
    if (threadIdx.x == 0) (void)xb_add(&bar[XB_XCNT(b.x)], 1u);
    return b;
}
__device__ __forceinline__ void xcd_barrier_complete(unsigned* bar, unsigned x, unsigned& nloc, unsigned& nx) {
    const unsigned G = gridDim.x * gridDim.y * gridDim.z;
    unsigned sum, cnt, mine, sp = 0u;
    for (;;) {
        sum = 0u; cnt = 0u; mine = 0u;
#pragma unroll
        for (unsigned j = 0; j < 16; ++j) { const unsigned c = xb_ld(&bar[XB_XCNT(j)]); sum += c; cnt += (c > 0u) ? 1u : 0u; mine = (j == x) ? c : mine; }
        if (sum == G) break;
        __builtin_amdgcn_s_sleep(1);
        if ((++sp & 255u) == 0u) { if (xb_ld(&bar[XB_TMO])) break; if (sp > XB_SPIN_CAP) { atomicAdd(&bar[XB_TMO], 1u); break; } }
    }
    nloc = mine > 0u ? mine : 1u; nx = cnt > 0u ? cnt : 1u;
}

__device__ __forceinline__ void xcd_barrier(const XcdBarrier& b) {
    asm volatile("s_waitcnt vmcnt(0)" ::: "memory");
    __syncthreads();
    if (threadIdx.x == 0) {
        unsigned* bar = b.bar;
        __builtin_amdgcn_s_waitcnt(0);
        unsigned nloc = b.st[0], nx = b.st[1];
        if (nloc == 0u) { xcd_barrier_complete(bar, b.x, nloc, nx); b.st[0] = nloc; b.st[1] = nx; }
        const unsigned old = xb_add(&bar[XB_XSUB(b.x)], 1u);
        const unsigned gen = old / nloc;
        if (old + 1u == (gen + 1u) * nloc) {
            __builtin_amdgcn_fence(__ATOMIC_RELEASE, "agent");
            asm volatile("s_waitcnt vmcnt(0)" ::: "memory");
            const unsigned og = xb_add(&bar[XB_TOP], 1u);
            const unsigned tg = og / nx;
            if (og + 1u == (tg + 1u) * nx) xb_add(&bar[XB_TOPGEN], 1u);
            else XB_SPIN(xb_ld(&bar[XB_TOPGEN]) == tg, bar);
            __builtin_amdgcn_fence(__ATOMIC_ACQUIRE, "agent");
            xb_add(&bar[XB_XGEN(b.x)], 1u);
            asm volatile("s_waitcnt vmcnt(0)" ::: "memory");
        } else {
            XB_SPIN(xb_ld(&bar[XB_XGEN(b.x)]) == gen, bar);
            __builtin_amdgcn_fence(__ATOMIC_ACQUIRE, "agent");
            asm volatile("s_waitcnt vmcnt(0)" ::: "memory");
        }
    }
    __syncthreads();
}
#define MK_ONE_LAUNCH 1
#define PROBE_MASK 0u
#ifndef MK_ONE_LAUNCH
#define MK_ONE_LAUNCH 1
#endif
constexpr int N_PHASES = 19;
__device__ __forceinline__ unsigned long long rt_now() { unsigned long long t; asm volatile("s_memrealtime %0\n\ts_waitcnt lgkmcnt(0)" : "=s"(t) :: "memory"); return t; }
__device__ __forceinline__ int bal16(int x) { const int k = x >> 4, c = x & 15; return (k << 4) + ((k & 1) ? 15 - c : c); }

__global__ void __launch_bounds__(512, 2) fwd(Args a) {
    extern __shared__ __attribute__((aligned(16))) unsigned char smem[];
    LAS char* lds = (LAS char*)smem;
    LAS unsigned* xbw = (LAS unsigned*)(lds + cfg::LDS_BYTES - 16);
    if (threadIdx.x < 4) xbw[threadIdx.x] = 0u;
    __syncthreads();
    XcdBarrier bar = xcd_barrier_post((unsigned*)(a.ws + wsm::CTL), (volatile LAS unsigned*)xbw);
    const int G = gridDim.x, wg = blockIdx.x;
    int pc = 0; bool on;
#ifndef PROBE_MASK
#define PROBE_MASK 0u
#endif
    unsigned long long ph_t0 = 0ull;
#ifdef PROBE_SUB
#define PROBE_SUBV 1
#else
#define PROBE_SUBV 0
#endif
#define PH_BEGIN() (ph_t0 = (PROBE_MASK ? rt_now() : 0ull), on = (pc >= a.ph_lo && pc < a.ph_hi))
#define PH_END() do { if (on && pc + 1 < a.ph_hi) xcd_barrier(bar); \
        if (PROBE_SUBV && ((PROBE_MASK >> pc) & 1u)) { __syncthreads(); const unsigned d_ = *(LAS unsigned*)(lds + cfg::LDS_BYTES - 8); const unsigned long long t1_ = rt_now(); while (rt_now() - t1_ < d_) __builtin_amdgcn_s_sleep(8); } \
        else if (PROBE_MASK && ((PROBE_MASK >> pc) & 1u)) { const unsigned long long t1_ = rt_now(), d_ = t1_ - ph_t0; while (rt_now() - t1_ < d_) __builtin_amdgcn_s_sleep(8); } \
        ++pc; } while (0)
    using namespace cfg;
    bf16_t* const xb = ph::wsb(a, wsm::XB); float* const ssq = ph::wsf(a, wsm::SSQ); bf16_t* const actz = ph::wsb(a, wsm::ACTZ); bf16_t* const mix = ph::wsb(a, wsm::MIX);

    if (PH_BEGIN()) ph::prologue(a, lds);
    PH_END();
#ifdef FIXED_DELAY_US
    { const unsigned long long t1_ = __builtin_amdgcn_s_memrealtime(); while (__builtin_amdgcn_s_memrealtime() - t1_ < (unsigned long long)FIXED_DELAY_US * 100ull) __builtin_amdgcn_s_sleep(8); }
#endif

    for (int L = 0; L < 2; ++L) {
        for (int hf = 0; hf < 2; ++hf) {
            if (hf == 1) {
                if (PH_BEGIN()) { pg8::Gemm g{xb, ph::wsb(a, wsm::WIN + L * wsm::WIN_1), M, ZLD, D}; pg8::StaticOrder so; so.init(M, ZLD, G, wg);
                    pg8::EpiZ E{actz, ZLD, ssq}; pg8::gemm_phase<pg8::EpiZ, pg8::StaticOrder, false>((PG8_LAS unsigned char*)smem, g, so, E, nullptr); }
                PH_END();
                if (L == 0) {
                    if (PH_BEGIN()) {
                        { SUBT_BEGIN(4); for (int u = wg; u < 768; u += G) ph::compress_unit(a, u, lds); SUBT_END(4, lds); }
                        { SUBT_BEGIN(5); for (int u = wg; u < 256; u += G) ph::gmlp_unit(a, u, lds); SUBT_END(5, lds); }
                        { SUBT_BEGIN(6); for (int u = wg; u < 1024; u += G) ph::rope_even_unit(a, u); SUBT_END(6, lds); }
                    }
                    PH_END();
                    if (PH_BEGIN()) {
                        for (int idx = wg; idx < 1536; idx += G) { const int b = idx & 15, rest = bal16(idx >> 4); ph::nsa_unit(a, b, rest % 3, rest / 3, lds); }
                    }
                    PH_END();
                } else {
                    if (PH_BEGIN()) { for (int u = wg; u < 1024; u += G) ph::rope_odd_unit(a, u); }
                    PH_END();
                    if (PH_BEGIN()) {
                        for (int idx = wg; idx < 2048; idx += G) ph::dsa_select_unit2(a, idx & 15, bal16(idx >> 4), lds);
                        for (int u = wg; u < 128; u += G) ph::kmean_unit(a, u, lds);
                    }
                    PH_END();
                    if (PH_BEGIN()) {
                        for (int idx = wg; idx < 1024; idx += G) ph::dsa_attn_unit(a, idx & 15, bal16(idx >> 4), lds);
                        for (int idx = wg; idx < 1024; idx += G) { const int r = bal16(idx >> 4); ph::moba_unit(a, idx & 15, r & 7, r >> 3, lds); }
                    }
                    PH_END();
                }
                if (PH_BEGIN()) {
#ifdef PROBE_SUB
                    if (PROBE_SUB >= 9 && PROBE_SUB <= 23 && PROBE_SUB != 20) { if (L == 0) chk::check_even(a, lds, PROBE_SUB); else chk::check_odd(a, lds, PROBE_SUB); __syncthreads(); }
#endif
                    pg8::Gemm g{mix, ph::wsb(a, wsm::WOUT + L * wsm::WOUT_1), M, D, D}; pg8::StaticOrder so; so.init(M, D, G, wg);
                    pg8::EpiResid E{xb, ssq, 1.0f}; pg8::gemm_phase<pg8::EpiResid, pg8::StaticOrder, false>((PG8_LAS unsigned char*)smem, g, so, E, nullptr); }
                PH_END();
            }
            const int f = 2 * L + hf;
            if (PH_BEGIN()) { pg8::Gemm g{xb, ph::wsb(a, wsm::WGU + f * wsm::WGU_1), M, NGU, D}; pg8::StaticOrder so; so.init(M, NGU, G, wg);
                pg8::EpiSwiGLU E{actz, ssq}; pg8::gemm_phase<pg8::EpiSwiGLU, pg8::StaticOrder, false>((PG8_LAS unsigned char*)smem, g, so, E, nullptr); }
            PH_END();
            if (PH_BEGIN()) { pg8::Gemm g{actz, ph::wsb(a, wsm::WD + f * wsm::WD_1), M, D, FF}; pg8::StaticOrder so; so.init(M, D, G, wg);
                pg8::EpiResid E{xb, ssq, 0.5f}; pg8::gemm_phase<pg8::EpiResid, pg8::StaticOrder, false>((PG8_LAS unsigned char*)smem, g, so, E, nullptr); }
            PH_END();
        }
    }
#ifdef PROBE_SUB
    if (PROBE_SUB == 20 || PROBE_SUB == 25) { const unsigned nbad = __hip_atomic_load((unsigned*)(a.ws + wsm::CTL) + 4000, __ATOMIC_RELAXED, __HIP_MEMORY_SCOPE_AGENT); const unsigned long long t1_ = rt_now(); while (rt_now() - t1_ < (unsigned long long)nbad * 100ull) __builtin_amdgcn_s_sleep(8); }
#endif
    if (PH_BEGIN()) ph::final_norm(a);
    PH_END();
#undef PH_BEGIN
#undef PH_END
}

extern "C" void kernel_launch(void* const* d_in, const int* in_sizes, int n_in, void* d_out, int out_size, void* d_ws, size_t ws_size, hipStream_t stream) {
    static int grid = 0;
    if (grid == 0) {
        if (n_in != 25 || out_size != cfg::M * cfg::D || ws_size < wsm::END) { fprintf(stderr, "kernel_launch: unexpected shapes (n_in %d, out %d, ws %zu < %zu)\n", n_in, out_size, ws_size, (size_t)wsm::END); grid = -1; return; }
        int dev = 0, cus = 0;
        if (hipGetDevice(&dev) != hipSuccess || hipDeviceGetAttribute(&cus, hipDeviceAttributeMultiprocessorCount, dev) != hipSuccess) { grid = -1; return; }
        if (hipFuncSetAttribute((const void*)fwd, hipFuncAttributeMaxDynamicSharedMemorySize, cfg::LDS_BYTES) != hipSuccess) { fprintf(stderr, "kernel_launch: hipFuncSetAttribute failed\n"); grid = -1; return; }
        int per_cu = 0; (void)hipOccupancyMaxActiveBlocksPerMultiprocessor(&per_cu, (const void*)fwd, 512, cfg::LDS_BYTES); (void)hipGetLastError();
        grid = cus;
    }
    if (grid < 0) return;
    (void)hipMemsetAsync((char*)d_ws + wsm::CTL, 0, wsm::CTL_BYTES, stream);
    Args a{};
    for (int i = 0; i < 25; ++i) a.in[i] = (const float*)d_in[i];
    a.out = (float*)d_out; a.ws = (unsigned char*)d_ws;
#if MK_ONE_LAUNCH
    a.ph_lo = 0; a.ph_hi = N_PHASES;
    hipLaunchKernelGGL(fwd, dim3(grid), dim3(512), cfg::LDS_BYTES, stream, a);
#else
    for (int p = 0; p < N_PHASES; ++p) { a.ph_lo = p; a.ph_hi = p + 1; hipLaunchKernelGGL(fwd, dim3(grid), dim3(512), cfg::LDS_BYTES, stream, a); }
#endif
}
```
